# Optimizing an MI355X kernel written in HIP

```python
import jax, jax.numpy as jnp
from jax import lax
import numpy as np

D_MODEL = 1024
BATCH = 16
SEQ = 2048
DEPTH = 1

D_MIX = D_MODEL
MLA_HEADS = 8
MLA_V_DIM = (D_MIX // 2) // MLA_HEADS
MLA_NOPE_DIM = 64
MLA_ROPE_DIM = 32
MLA_QK_DIM = MLA_NOPE_DIM + MLA_ROPE_DIM
MLA_Q_LORA = 384
MLA_KV_LORA = 256
ROPE_THETA = 10000.0
Q_BLOCK = 128
HG_HEADS = 4
HG_HEAD_DIM = (D_MIX // 2) // HG_HEADS
HG_WIDTH = HG_HEADS * HG_HEAD_DIM
HG_CHUNK = 64
N_GROUPS = 4
EXPERTS_PER_GROUP = 8
N_EXPERTS = N_GROUPS * EXPERTS_PER_GROUP
TOP_K = 2
D_EXPERT = D_MODEL // 2
MOE_BLOCK = 128
EPS = 1e-6
IN_SPLITS = (MLA_Q_LORA, MLA_KV_LORA, MLA_ROPE_DIM, HG_WIDTH, HG_WIDTH, HG_WIDTH, HG_WIDTH, HG_WIDTH)
IN_COLS = MLA_Q_LORA + MLA_KV_LORA + MLA_ROPE_DIM + 5 * HG_WIDTH

kernel_name = 'hymba_mla_hgrn2_hmoe_adaln_encoder'


def rms_norm(x, g):
    xf = x.astype(jnp.float32)
    y = xf * lax.rsqrt(jnp.mean(xf * xf, axis=-1, keepdims=True) + EPS)
    return (y * g.astype(jnp.float32)).astype(x.dtype)


def modulate(h, shift, scale):
    return h * (1 + scale[:, None, :]) + shift[:, None, :]


def apply_rope(x, positions):
    half = MLA_ROPE_DIM // 2
    inv_freq = ROPE_THETA ** (-jnp.arange(half, dtype=jnp.float32) / half)
    ang = positions.astype(jnp.float32)[:, :, None, None] * inv_freq
    cos, sin = jnp.cos(ang), jnp.sin(ang)
    xf = x.astype(jnp.float32)
    x1, x2 = xf[..., :half], xf[..., half:]
    return jnp.concatenate([x1 * cos - x2 * sin, x2 * cos + x1 * sin], axis=-1).astype(x.dtype)


def mla_mixer(q_lat, kv_lat, k_rope, positions, qa_g, wq_up, kva_g, wkv_up, qn_g, kn_g):
    B, S, _ = q_lat.shape
    q = (rms_norm(q_lat, qa_g) @ wq_up).reshape(B, S, MLA_HEADS, MLA_QK_DIM)
    kv = (rms_norm(kv_lat, kva_g) @ wkv_up).reshape(B, S, MLA_HEADS, MLA_NOPE_DIM + MLA_V_DIM)
    k_nope, v = kv[..., :MLA_NOPE_DIM], kv[..., MLA_NOPE_DIM:]
    k_shared = jnp.broadcast_to(k_rope[:, :, None, :], (B, S, MLA_HEADS, MLA_ROPE_DIM))
    k = jnp.concatenate([k_nope, k_shared], axis=-1)
    q = rms_norm(q, qn_g)
    k = rms_norm(k, kn_g)
    q = jnp.concatenate([q[..., :MLA_NOPE_DIM], apply_rope(q[..., MLA_NOPE_DIM:], positions)], axis=-1)
    k = jnp.concatenate([k[..., :MLA_NOPE_DIM], apply_rope(k[..., MLA_NOPE_DIM:], positions)], axis=-1)
    scale = MLA_QK_DIM ** -0.5
    n_blocks = S // Q_BLOCK
    q_blocks = q.reshape(B, n_blocks, Q_BLOCK, MLA_HEADS, MLA_QK_DIM).transpose(1, 0, 2, 3, 4)

    def attend(qb):
        s = jnp.einsum('bqhd,bkhd->bhqk', qb, k).astype(jnp.float32) * scale
        p = jax.nn.softmax(s, axis=-1).astype(v.dtype)
        return jnp.einsum('bhqk,bkhv->bqhv', p, v)

    o = lax.map(attend, q_blocks)
    return o.transpose(1, 0, 2, 3, 4).reshape(B, S, MLA_HEADS * MLA_V_DIM)


def gla_chunk_scan(q, k, v, log_f):
    B, S, H, K = q.shape
    V = v.shape[-1]
    N = S // HG_CHUNK

    def to_chunks(t):
        return t.reshape(B, N, HG_CHUNK, H, t.shape[-1]).transpose(0, 3, 1, 2, 4)

    q, k, v, log_f = to_chunks(q), to_chunks(k), to_chunks(v), to_chunks(log_f)
    b = jnp.cumsum(log_f, axis=3)
    b_last = b[:, :, :, -1:, :]
    q_dec = q * jnp.exp(b)
    att = jnp.einsum('bhnck,bhnsk->bhncs', q_dec, k * jnp.exp(-b))
    mask = jnp.tril(jnp.ones((HG_CHUNK, HG_CHUNK), dtype=bool))
    att = jnp.where(mask, att, 0.0)
    o_intra = jnp.einsum('bhncs,bhnsv->bhncv', att, v)
    kv = jnp.einsum('bhnck,bhncv->bhnkv', k * jnp.exp(b_last - b), v)
    decay = jnp.exp(b_last[:, :, :, 0, :])

    def step(state, inp):
        d, u = inp
        return d[..., None] * state + u, state

    init = jnp.zeros((B, H, K, V), q.dtype)
    _, s_prev = lax.scan(step, init, (jnp.moveaxis(decay, 2, 0), jnp.moveaxis(kv, 2, 0)))
    s_prev = jnp.moveaxis(s_prev, 0, 2)
    o = o_intra + jnp.einsum('bhnck,bhnkv->bhncv', q_dec, s_prev)
    return o.transpose(0, 2, 3, 1, 4).reshape(B, S, H, V)


def hgrn2_mixer(hq, hf_fwd, hf_bwd, hi, hg, lower, norm_g):
    B, S, _ = hq.shape

    def heads(t):
        return t.reshape(B, S, HG_HEADS, HG_HEAD_DIM).astype(jnp.float32)

    q = jax.nn.silu(heads(hq))
    v = heads(hi)

    def gates(f_logits, lb):
        lb = lb.reshape(HG_HEADS, HG_HEAD_DIM)
        f = lb + (1.0 - lb) * jax.nn.sigmoid(heads(f_logits))
        return 1.0 - f, jnp.log(f)

    k_f, lf_f = gates(hf_fwd, lower[0])
    k_b, lf_b = gates(hf_bwd, lower[1])
    o_fwd = gla_chunk_scan(q, k_f, v, lf_f)

    def flip(t):
        return jnp.flip(t, axis=1)

    o_bwd = flip(gla_chunk_scan(flip(q), flip(k_b), flip(v), flip(lf_b)))
    o = rms_norm(o_fwd + o_bwd, norm_g) * jax.nn.silu(heads(hg))
    return o.reshape(B, S, HG_WIDTH).astype(hq.dtype)


def hierarchical_moe(h, wg, bg, we, be, w_gate, w_up, w_down):
    B, S, D = h.shape
    T = B * S
    A = T * TOP_K
    ht = h.reshape(T, D)
    group_prob = jax.nn.softmax((ht @ wg).astype(jnp.float32) + bg.astype(jnp.float32), axis=-1)
    group_p, group_idx = lax.top_k(group_prob, 1)
    expert_logits = ((ht @ we).astype(jnp.float32) + be.astype(jnp.float32)).reshape(T, N_GROUPS, EXPERTS_PER_GROUP)
    in_group = jnp.take_along_axis(expert_logits, group_idx[:, :, None], axis=1)[:, 0]
    top_val, top_idx = lax.top_k(in_group, TOP_K)
    weights = group_p * jax.nn.softmax(top_val, axis=-1)
    expert_id = group_idx * EXPERTS_PER_GROUP + top_idx
    e_flat = expert_id.reshape(A)
    tok_flat = jnp.repeat(jnp.arange(T, dtype=jnp.int32), TOP_K)
    w_flat = weights.reshape(A)
    order = jnp.argsort(e_flat)
    e_sorted = e_flat[order]
    counts = jnp.bincount(e_flat, length=N_EXPERTS)
    padded = (counts + MOE_BLOCK - 1) // MOE_BLOCK * MOE_BLOCK
    starts = jnp.cumsum(counts) - counts
    padded_ends = jnp.cumsum(padded)
    padded_starts = padded_ends - padded
    dest = padded_starts[e_sorted] + jnp.arange(A, dtype=jnp.int32) - starts[e_sorted]
    cap = A + N_EXPERTS * MOE_BLOCK
    n_blocks = cap // MOE_BLOCK
    buf_tok = jnp.zeros((cap,), jnp.int32).at[dest].set(tok_flat[order])
    buf_w = jnp.zeros((cap,), h.dtype).at[dest].set(w_flat[order].astype(h.dtype))
    block_expert = jnp.clip(jnp.searchsorted(padded_ends, jnp.arange(n_blocks, dtype=jnp.int32) * MOE_BLOCK, side='right'), 0, N_EXPERTS - 1)
    xb = ht[buf_tok].reshape(n_blocks, MOE_BLOCK, D)

    def expert_block(args):
        xe, e = args
        hid = jax.nn.silu(xe @ w_gate[e]) * (xe @ w_up[e])
        return hid @ w_down[e]

    yb = lax.map(expert_block, (xb, block_expert)).reshape(cap, D)
    out = jnp.zeros((T, D), h.dtype).at[buf_tok].add(yb * buf_w[:, None])
    return out.reshape(B, S, D)


def setup_inputs(seed: int = 0) -> dict:
    key = jax.random.key(seed)
    ks = jax.random.split(key, 24)
    f32 = jnp.float32
    L = DEPTH

    def nrm(k, shape, fan_in):
        return jax.random.normal(k, shape, f32) * fan_in ** -0.5

    def gain(k, shape):
        return 1.0 + 0.05 * jax.random.normal(k, shape, f32)

    return {
        'x': jax.random.normal(ks[0], (BATCH, SEQ, D_MODEL), f32),
        'c': jax.random.normal(ks[1], (BATCH, D_MODEL), f32),
        'positions': jnp.arange(SEQ, dtype=jnp.int32)[None, :] + jax.random.randint(ks[2], (BATCH, 1), 0, 4096, dtype=jnp.int32),
        'ada_w': nrm(ks[3], (L, D_MODEL, 6 * D_MODEL), D_MODEL),
        'ada_b': 0.02 * jax.random.normal(ks[4], (L, 6 * D_MODEL), f32),
        'norm1_g': gain(ks[5], (L, D_MODEL)),
        'w_in': nrm(ks[6], (L, D_MODEL, IN_COLS), D_MODEL),
        'mla_qa_g': gain(ks[7], (L, MLA_Q_LORA)),
        'mla_wq_up': nrm(ks[8], (L, MLA_Q_LORA, MLA_HEADS * MLA_QK_DIM), MLA_Q_LORA),
        'mla_kva_g': gain(ks[9], (L, MLA_KV_LORA)),
        'mla_wkv_up': nrm(ks[10], (L, MLA_KV_LORA, MLA_HEADS * (MLA_NOPE_DIM + MLA_V_DIM)), MLA_KV_LORA),
        'mla_qn_g': gain(ks[11], (L, MLA_QK_DIM)),
        'mla_kn_g': gain(ks[12], (L, MLA_QK_DIM)),
        'hg_lb_logits': 0.1 * jax.random.normal(ks[13], (2, L + 1, HG_WIDTH), f32),
        'hg_norm_g': gain(ks[14], (L, HG_HEAD_DIM)),
        'w_out': nrm(ks[15], (L, D_MIX, D_MODEL), D_MIX),
        'norm2_g': gain(ks[16], (L, D_MODEL)),
        'router_group_w': nrm(ks[17], (L, D_MODEL, N_GROUPS), D_MODEL),
        'router_group_b': 0.01 * jax.random.normal(ks[18], (L, N_GROUPS), f32),
        'router_expert_w': nrm(ks[19], (L, D_MODEL, N_EXPERTS), D_MODEL),
        'router_expert_b': 0.01 * jax.random.normal(ks[20], (L, N_EXPERTS), f32),
        'w_gate': nrm(ks[21], (L, N_EXPERTS, D_MODEL, D_EXPERT), D_MODEL),
        'w_up': nrm(ks[22], (L, N_EXPERTS, D_MODEL, D_EXPERT), D_MODEL),
        'w_down': nrm(ks[23], (L, N_EXPERTS, D_EXPERT, D_MODEL), D_EXPERT),
    }


def reference(x, c, positions, ada_w, ada_b, norm1_g, w_in, mla_qa_g, mla_wq_up, mla_kva_g, mla_wkv_up, mla_qn_g, mla_kn_g, hg_lb_logits, hg_norm_g, w_out, norm2_g, router_group_w, router_group_b, router_expert_w, router_expert_b, w_gate, w_up, w_down):
    lower_bounds = jnp.cumsum(jax.nn.softmax(hg_lb_logits.astype(jnp.float32), axis=1), axis=1)
    split_points = [int(p) for p in np.cumsum(IN_SPLITS)[:-1]]
    c_act = jax.nn.silu(c)
    for layer in range(DEPTH):
        mod = c_act @ ada_w[layer] + ada_b[layer]
        shift1, scale1, gate1, shift2, scale2, gate2 = jnp.split(mod, 6, axis=-1)
        h = modulate(rms_norm(x, norm1_g[layer]), shift1, scale1)
        proj = h @ w_in[layer]
        q_lat, kv_lat, k_rope, hg_q, hg_f_fwd, hg_f_bwd, hg_i, hg_g = jnp.split(proj, split_points, axis=-1)
        attn_out = mla_mixer(q_lat, kv_lat, k_rope, positions, mla_qa_g[layer], mla_wq_up[layer], mla_kva_g[layer], mla_wkv_up[layer], mla_qn_g[layer], mla_kn_g[layer])
        rec_out = hgrn2_mixer(hg_q, hg_f_fwd, hg_f_bwd, hg_i, hg_g, lower_bounds[:, layer], hg_norm_g[layer])
        mixed = jnp.concatenate([attn_out, rec_out], axis=-1) @ w_out[layer]
        x = x + gate1[:, None, :] * mixed
        h2 = modulate(rms_norm(x, norm2_g[layer]), shift2, scale2)
        moe_out = hierarchical_moe(h2, router_group_w[layer], router_group_b[layer], router_expert_w[layer], router_expert_b[layer], w_gate[layer], w_up[layer], w_down[layer])
        x = x + gate2[:, None, :] * moe_out
    return x
```

```cpp
#include <hip/hip_runtime.h>
#include <hip/hip_cooperative_groups.h>
#include <stdint.h>
#include <stdio.h>
namespace cg = cooperative_groups;

#define D_MODEL 1024
#define BATCH 16
#define SEQ 2048
#define NTOK (BATCH * SEQ)
#define MLA_HEADS 8
#define QK_DIM 96
#define V_DIM 64
#define NOPE 64
#define ROPE 32
#define Q_LORA 384
#define KV_LORA 256
#define HG_HEADS 4
#define HG_DIM 128
#define HG_W 512
#define IN_COLS 3232
#define N_EXP 32
#define D_EXP 512
#define NASSIGN (NTOK * 2)
#define EPS 1e-6f
#define C_HQ 0
#define C_HFF 512
#define C_HFB 1024
#define C_HI 1536
#define C_HG 2048
#define C_QLAT 2560
#define C_KVLAT 2944
#define C_KROPE 3200

typedef unsigned short bf16_t;

__device__ __forceinline__ float bf2f(bf16_t v) { return __uint_as_float(((unsigned)v) << 16); }
__device__ __forceinline__ bf16_t f2bf(float f) {
  unsigned u = __float_as_uint(f);
  u += 0x7fffu + ((u >> 16) & 1u);
  return (bf16_t)(u >> 16);
}
__device__ __forceinline__ int otid() { int t = threadIdx.x; asm volatile("" : "+v"(t)); return t; }
__device__ __forceinline__ float silu_f(float x) { return x / (1.f + __expf(-x)); }
__device__ __forceinline__ float sigmoid_f(float x) { return 1.f / (1.f + __expf(-x)); }

__device__ __forceinline__ float wave_sum(float v) {
#pragma unroll
  for (int o = 32; o > 0; o >>= 1) v += __shfl_xor(v, o);
  return v;
}
__device__ __forceinline__ float wave_max(float v) {
#pragma unroll
  for (int o = 32; o > 0; o >>= 1) v = fmaxf(v, __shfl_xor(v, o));
  return v;
}
__device__ __forceinline__ float block_sum256(float v, float* red) {
  v = wave_sum(v);
  __syncthreads();
  if ((threadIdx.x & 63) == 0) red[threadIdx.x >> 6] = v;
  __syncthreads();
  return red[0] + red[1] + red[2] + red[3];
}

struct Params {
  const float* x; const float* c; const int* pos;
  const float* ada_w; const float* ada_b; const float* norm1_g; const float* w_in;
  const float* qa_g; const float* wq_up; const float* kva_g; const float* wkv_up;
  const float* qn_g; const float* kn_g; const float* lb_logits; const float* hg_norm_g;
  const float* w_out; const float* norm2_g; const float* rg_w; const float* rg_b;
  const float* re_w; const float* re_b; const float* w_gate; const float* w_up; const float* w_down;
  float* out;
  float* mod;
  float* lb;
  float* cs;
  bf16_t* h;
  bf16_t* proj;
  bf16_t* mix;
  float* o_f;
  float* o_b;
  bf16_t* qkv_raw;
  bf16_t* Q;
  bf16_t* Kk;
  bf16_t* V;
  int* eid;
  float* ewt;
  int* cnt;
  int* qctr;
  int* hcnt;
  float* rwt;
  unsigned* bar;
  int* list;
  bf16_t* hid;
  bf16_t* y;
  bf16_t* of16;
  bf16_t* hiT;
  bf16_t* w_in_t;
  bf16_t* wq_t;
  bf16_t* wkv_t;
  bf16_t* w_out_t;
  bf16_t* wgu_t;
  bf16_t* wd_t;
};

__global__ void k_misc(Params p) {
  int i = blockIdx.x * blockDim.x + threadIdx.x;
  if (i < 2 * HG_W) {
    int d = i / HG_W, w = i % HG_W;
    float l0 = p.lb_logits[(d * 2 + 0) * HG_W + w], l1 = p.lb_logits[(d * 2 + 1) * HG_W + w];
    float m = fmaxf(l0, l1);
    float e0 = expf(l0 - m), e1 = expf(l1 - m);
    p.lb[i] = e0 / (e0 + e1);
  }
  if (i < NTOK * 16) {
    int t = i >> 4, j = i & 15;
    float inv = powf(10000.0f, -(float)j / 16.0f);
    float ang = (float)p.pos[t] * inv;
    p.cs[t * 32 + j] = cosf(ang);
    p.cs[t * 32 + 16 + j] = sinf(ang);
  }
  if (i < N_EXP) p.cnt[i] = 0;
}

__global__ void k_mod(Params p) {
  __shared__ float ca[D_MODEL];
  int b = blockIdx.y;
  for (int k = threadIdx.x; k < D_MODEL; k += blockDim.x) ca[k] = silu_f(p.c[b * D_MODEL + k]);
  __syncthreads();
  int n = blockIdx.x * blockDim.x + threadIdx.x;
  float acc = 0.f;
  for (int k = 0; k < D_MODEL; ++k) acc += ca[k] * p.ada_w[(size_t)k * 6144 + n];
  p.mod[b * 6144 + n] = acc + p.ada_b[n];
}

__global__ void k_norm1(Params p) {
  __shared__ float red[4];
  int t = blockIdx.x, b = t / SEQ;
  const float4 xv = ((const float4*)(p.x + (size_t)t * D_MODEL))[threadIdx.x];
  float ss = xv.x * xv.x + xv.y * xv.y + xv.z * xv.z + xv.w * xv.w;
  ss = block_sum256(ss, red);
  float rstd = rsqrtf(ss * (1.f / D_MODEL) + EPS);
  int c0 = threadIdx.x * 4;
  const float* shift = p.mod + b * 6144, * scale = p.mod + b * 6144 + 1024;
  float v[4] = {xv.x, xv.y, xv.z, xv.w};
  bf16_t o[4];
#pragma unroll
  for (int j = 0; j < 4; ++j) o[j] = f2bf(v[j] * rstd * p.norm1_g[c0 + j] * (1.f + scale[c0 + j]) + shift[c0 + j]);
  ushort4 ov = {o[0], o[1], o[2], o[3]};
  ((ushort4*)(p.h + (size_t)t * D_MODEL))[threadIdx.x] = ov;
}

struct GemmSmem { float a[16][68]; float b[16][68]; };

template <class Epi>
__device__ __forceinline__ void gemm_tile_naive(const bf16_t* __restrict__ A, int lda, const int* arow  ,
                                                const float* __restrict__ B, int ldb, int K, int m0, int n0, int N,
                                                GemmSmem& s, Epi epi) {
  const int tid = threadIdx.x, ty = tid >> 4, tx = tid & 15;
  float acc[4][4];
#pragma unroll
  for (int i = 0; i < 4; ++i)
#pragma unroll
    for (int j = 0; j < 4; ++j) acc[i][j] = 0.f;
  const int ar = tid >> 2, ak = (tid & 3) * 4;
  const int bk = tid >> 4, bc = (tid & 15) * 4;
  long arow_g = arow ? (long)arow[ar] : (long)(m0 + ar);
  for (int k0 = 0; k0 < K; k0 += 16) {
    ushort4 av = {0, 0, 0, 0};
    if (arow_g >= 0) av = *(const ushort4*)(A + arow_g * lda + k0 + ak);
    float4 bv = {0.f, 0.f, 0.f, 0.f};
    {
      const float* bp = B + (size_t)(k0 + bk) * ldb + n0 + bc;
      if (n0 + bc + 3 < N) bv = *(const float4*)bp;
      else {
        if (n0 + bc + 0 < N) bv.x = bp[0];
        if (n0 + bc + 1 < N) bv.y = bp[1];
        if (n0 + bc + 2 < N) bv.z = bp[2];
      }
    }
    __syncthreads();
    s.a[ak + 0][ar] = bf2f(av.x); s.a[ak + 1][ar] = bf2f(av.y); s.a[ak + 2][ar] = bf2f(av.z); s.a[ak + 3][ar] = bf2f(av.w);
    *(float4*)&s.b[bk][bc] = bv;
    __syncthreads();
#pragma unroll
    for (int kk = 0; kk < 16; ++kk) {
      float4 a4 = *(const float4*)&s.a[kk][ty * 4];
      float4 b4 = *(const float4*)&s.b[kk][tx * 4];
      float a_[4] = {a4.x, a4.y, a4.z, a4.w}, b_[4] = {b4.x, b4.y, b4.z, b4.w};
#pragma unroll
      for (int i = 0; i < 4; ++i)
#pragma unroll
        for (int j = 0; j < 4; ++j) acc[i][j] += a_[i] * b_[j];
    }
  }
#pragma unroll
  for (int i = 0; i < 4; ++i)
#pragma unroll
    for (int j = 0; j < 4; ++j) {
      int n = n0 + tx * 4 + j;
      if (n < N) epi(ty * 4 + i, n, acc[i][j]);
    }
}


__device__ __forceinline__ int win_perm(int n) {
  if (n < 384) return C_QLAT + n;
  if (n < 640) return C_KVLAT + (n - 384);
  if (n < 672) return C_KROPE + (n - 640);
  if (n < 3232) return n - 672;
  return n;
}
template <bool WIN_PERM = false>
__device__ __forceinline__ void cvt_tile(const float* __restrict__ src, int ld_src, int K, int N, int k0, int n0,
                                         bf16_t* __restrict__ dst, int ld_dst, int dst_row0, const float* kscale, float* tile) {
  const int tid = otid();
  for (int e = tid; e < 4096; e += 256) {
    int kk = e >> 6, nn = e & 63;
    float v = 0.f;
    if (n0 + nn < N && k0 + kk < K) v = src[(size_t)(k0 + kk) * ld_src + n0 + nn];
    if (kscale) v *= kscale[k0 + kk];
    tile[kk * 65 + nn] = v;
  }
  __syncthreads();
  for (int e = tid; e < 4096; e += 256) {
    int nn = e >> 6, kk = e & 63;
    int drow = WIN_PERM ? win_perm(n0 + nn) : dst_row0 + nn;
    dst[(size_t)drow * ld_dst + k0 + kk] = f2bf(tile[kk * 65 + nn]);
  }
  __syncthreads();
}

#define CVT_WIN_TILES (16 * 52)
#define CVT_WQ_TILES (6 * 12)
#define CVT_WKV_TILES (4 * 16)
#define CVT_WOUT_TILES (16 * 16)
#define CVT_EXP_TILES (N_EXP * 384)
#define CVT_TOTAL (CVT_WIN_TILES + CVT_WQ_TILES + CVT_WKV_TILES + CVT_WOUT_TILES + CVT_EXP_TILES)

__device__ __forceinline__ void cvt_job(const Params& p, int job, float* tile) {
  if (job < CVT_WIN_TILES) {
    int kt = job / 52, nt = job % 52;
    cvt_tile<true>(p.w_in, IN_COLS, D_MODEL, IN_COLS, kt * 64, nt * 64, p.w_in_t, D_MODEL, nt * 64, nullptr, tile);
    return;
  }
  job -= CVT_WIN_TILES;
  if (job < CVT_WQ_TILES) {
    int kt = job / 12, nt = job % 12;
    cvt_tile(p.wq_up, 768, Q_LORA, 768, kt * 64, nt * 64, p.wq_t, Q_LORA, nt * 64, p.qa_g, tile);
    return;
  }
  job -= CVT_WQ_TILES;
  if (job < CVT_WKV_TILES) {
    int kt = job / 16, nt = job % 16;
    cvt_tile(p.wkv_up, 1024, KV_LORA, 1024, kt * 64, nt * 64, p.wkv_t, KV_LORA, nt * 64, p.kva_g, tile);
    return;
  }
  job -= CVT_WKV_TILES;
  if (job < CVT_WOUT_TILES) {
    int kt = job / 16, nt = job % 16;
    cvt_tile(p.w_out, D_MODEL, D_MODEL, D_MODEL, kt * 64, nt * 64, p.w_out_t, D_MODEL, nt * 64, nullptr, tile);
    return;
  }
  job -= CVT_WOUT_TILES;
  {
    int e = job / 384, r = job % 384;
    if (r < 128) {
      int kt = r / 8, nt = r % 8;
      cvt_tile(p.w_gate + (size_t)e * D_MODEL * D_EXP, D_EXP, D_MODEL, D_EXP, kt * 64, nt * 64,
               p.wgu_t + (size_t)e * 1024 * 1024, D_MODEL, nt * 128, nullptr, tile);
    } else if (r < 256) {
      r -= 128;
      int kt = r / 8, nt = r % 8;
      cvt_tile(p.w_up + (size_t)e * D_MODEL * D_EXP, D_EXP, D_MODEL, D_EXP, kt * 64, nt * 64,
               p.wgu_t + (size_t)e * 1024 * 1024, D_MODEL, nt * 128 + 64, nullptr, tile);
    } else {
      r -= 256;
      int kt = r / 16, nt = r % 16;
      cvt_tile(p.w_down + (size_t)e * D_EXP * D_MODEL, D_MODEL, D_EXP, D_MODEL, kt * 64, nt * 64,
               p.wd_t + (size_t)e * 1024 * 512, D_EXP, nt * 64, nullptr, tile);
    }
  }
}

#define CVT_SMALL (CVT_TOTAL - CVT_EXP_TILES)
__global__ void __launch_bounds__(256) k_cvt(Params p, int j0, int j1) {
  __shared__ float tile[64 * 65];
  for (int job = j0 + blockIdx.x; job < j1; job += gridDim.x) cvt_job(p, job, tile);
}

typedef __bf16 bf16n2 __attribute__((ext_vector_type(2)));
typedef float f32x2 __attribute__((ext_vector_type(2)));
__device__ __forceinline__ unsigned pack2bf(float a, float b) {
  f32x2 v = {a, b};
  return __builtin_bit_cast(unsigned, __builtin_convertvector(v, bf16n2));
}


using bf16x8 = __attribute__((ext_vector_type(8))) short;
using f32x4 = __attribute__((ext_vector_type(4))) float;
using u32x4 = __attribute__((ext_vector_type(4))) unsigned;
#define SC_LD 132
#define GEMM_SMEM_BYTES (64 * SC_LD * 4)

template <class Epi>
__device__ __forceinline__ void gemm128(const bf16_t* __restrict__ A, long lda, const int* arow, int m0,
                                        const bf16_t* __restrict__ Bt, long ldb, int n0, int K, char* smem, Epi epi) {
  const int tid = otid(), lane = tid & 63, wid = tid >> 6, wm = wid >> 1, wn = wid & 1;
  char* sA = smem;
  char* sB = smem + 16384;
  float* sC = (float*)smem;
  f32x4 acc[4][4];
#pragma unroll
  for (int i = 0; i < 4; ++i)
#pragma unroll
    for (int j = 0; j < 4; ++j) acc[i][j] = (f32x4){0.f, 0.f, 0.f, 0.f};
  const bf16_t* ap[4];
  const bf16_t* bp[4];
  int soff[4];
#pragma unroll
  for (int i = 0; i < 4; ++i) {
    int c = tid + 256 * i, row = c >> 3, ch = c & 7;
    long ar = arow ? (long)arow[row] : (long)(m0 + row);
    if (ar < 0) ar = 0;
    ap[i] = A + ar * lda + ch * 8;
    bp[i] = Bt + (long)(n0 + row) * ldb + ch * 8;
    soff[i] = row * 128 + ((ch ^ (row & 7)) << 4);
  }
  u32x4 ra[4], rb[4];
#pragma unroll
  for (int i = 0; i < 4; ++i) {
    ra[i] = *(const u32x4*)(ap[i]);
    rb[i] = *(const u32x4*)(bp[i]);
  }
  const int frow = lane & 15, fq = lane >> 4;
  auto stage_store = [&]() {
#pragma unroll
    for (int i = 0; i < 4; ++i) {
      *(u32x4*)(sA + soff[i]) = ra[i];
      *(u32x4*)(sB + soff[i]) = rb[i];
    }
  };
  auto compute = [&]() {
#pragma unroll
    for (int ks = 0; ks < 2; ++ks) {
      bf16x8 af[4], bfr[4];
#pragma unroll
      for (int i = 0; i < 4; ++i) {
        int row = wm * 64 + i * 16 + frow;
        af[i] = *(const bf16x8*)(sA + row * 128 + (((ks * 4 + fq) ^ (row & 7)) << 4));
      }
#pragma unroll
      for (int j = 0; j < 4; ++j) {
        int row = wn * 64 + j * 16 + frow;
        bfr[j] = *(const bf16x8*)(sB + row * 128 + (((ks * 4 + fq) ^ (row & 7)) << 4));
      }
#pragma unroll
      for (int i = 0; i < 4; ++i)
#pragma unroll
        for (int j = 0; j < 4; ++j) acc[i][j] = __builtin_amdgcn_mfma_f32_16x16x32_bf16(af[i], bfr[j], acc[i][j], 0, 0, 0);
    }
  };
  for (int k0 = 64; k0 < K; k0 += 64) {
    __syncthreads();
    stage_store();
    __syncthreads();
#pragma unroll
    for (int i = 0; i < 4; ++i) {
      ra[i] = *(const u32x4*)(ap[i] + k0);
      rb[i] = *(const u32x4*)(bp[i] + k0);
    }
    compute();
  }
  __syncthreads();
  stage_store();
  __syncthreads();
  compute();
#pragma unroll
  for (int half = 0; half < 2; ++half) {
    __syncthreads();
    if (wm == half) {
#pragma unroll
      for (int i = 0; i < 4; ++i)
#pragma unroll
        for (int j = 0; j < 4; ++j)
#pragma unroll
          for (int r = 0; r < 4; ++r) sC[(i * 16 + fq * 4 + r) * SC_LD + wn * 64 + j * 16 + frow] = acc[i][j][r];
    }
    __syncthreads();
    epi(half, sC);
  }
}

__device__ __forceinline__ void proj_tile(const Params& p, int t, char* smem) {
  const int NT = 26;
  int mt = t / NT, nt = t % NT;
  int m0 = mt * 128, n0 = nt * 128;
  bf16_t* C = p.proj;
  gemm128(p.h, D_MODEL, nullptr, m0, p.w_in_t, D_MODEL, n0, D_MODEL, smem, [&](int half, const float* sC) {
    const int tid = otid();
    if (nt >= 12 && nt < 16) {
      int vv = tid & 127, g = tid >> 7;
      int b = m0 / SEQ, hh = nt - 12;
      int sidx0 = m0 - b * SEQ + half * 64 + g * 32;
      bf16_t* dst = p.hiT + ((size_t)(b * HG_HEADS + hh) * HG_DIM + vv) * SEQ + sidx0;
#pragma unroll
      for (int q = 0; q < 4; ++q) {
        float t8[8];
#pragma unroll
        for (int e = 0; e < 8; ++e) t8[e] = sC[(g * 32 + q * 8 + e) * SC_LD + vv];
        u32x4 o = {pack2bf(t8[0], t8[1]), pack2bf(t8[2], t8[3]), pack2bf(t8[4], t8[5]), pack2bf(t8[6], t8[7])};
        *(u32x4*)(dst + q * 8) = o;
      }
    } else {
      int c8 = (tid & 15) * 8;
      if (n0 + c8 < IN_COLS) {
#pragma unroll
        for (int pass = 0; pass < 4; ++pass) {
          int r = pass * 16 + (tid >> 4);
          const float* src = sC + r * SC_LD + c8;
          float4 v0 = *(const float4*)src, v1 = *(const float4*)(src + 4);
          u32x4 o = {pack2bf(v0.x, v0.y), pack2bf(v0.z, v0.w), pack2bf(v1.x, v1.y), pack2bf(v1.z, v1.w)};
          *(u32x4*)(C + (size_t)(m0 + half * 64 + r) * IN_COLS + n0 + c8) = o;
        }
      }
    }
  });
}
__global__ void __launch_bounds__(256) k_gemm_proj_mfma(Params p) {
  __shared__ __attribute__((aligned(16))) char smem[GEMM_SMEM_BYTES];
  for (int t = blockIdx.x; t < (NTOK / 128) * 26; t += gridDim.x) proj_tile(p, t, smem);
}

#define SMEM_EXTRA_OFF GEMM_SMEM_BYTES
#define SMEM_TOTAL (GEMM_SMEM_BYTES + 1024)

__device__ __forceinline__ void outproj_tile(const Params& p, int t, char* smem) {
  int mt = t >> 3, nt = t & 7;
  int m0 = mt * 128, n0 = nt * 128;
  gemm128(p.mix, D_MODEL, nullptr, m0, p.w_out_t, D_MODEL, n0, D_MODEL, smem, [&](int half, const float* sC) {
    const int tid = otid();
    int c8 = (tid & 15) * 8;
    int b = m0 / SEQ;
    const float* gate = p.mod + b * 6144 + 2048 + n0 + c8;
    float4 g0 = *(const float4*)gate, g1 = *(const float4*)(gate + 4);
#pragma unroll
    for (int pass = 0; pass < 4; ++pass) {
      int r = pass * 16 + (tid >> 4);
      const float* src = sC + r * SC_LD + c8;
      float4 v0 = *(const float4*)src, v1 = *(const float4*)(src + 4);
      size_t go = (size_t)(m0 + half * 64 + r) * D_MODEL + n0 + c8;
      float4 x0 = *(const float4*)(p.x + go), x1 = *(const float4*)(p.x + go + 4);
      x0.x += g0.x * v0.x; x0.y += g0.y * v0.y; x0.z += g0.z * v0.z; x0.w += g0.w * v0.w;
      x1.x += g1.x * v1.x; x1.y += g1.y * v1.y; x1.z += g1.z * v1.z; x1.w += g1.w * v1.w;
      *(float4*)(p.out + go) = x0;
      *(float4*)(p.out + go + 4) = x1;
    }
  });
}
__global__ void __launch_bounds__(256) k_outproj_mfma(Params p) {
  __shared__ __attribute__((aligned(16))) char smem[SMEM_TOTAL];
  for (int t = blockIdx.x; t < (NTOK / 128) * 8; t += gridDim.x) outproj_tile(p, t, smem);
}

__device__ __forceinline__ void mla_up_tile(const Params& p, int t, char* smem) {
  const int tid = otid();
  int mt = t >> 4, u = t & 15;
  int m0 = mt * 128;
  float* rs = (float*)(smem + SMEM_EXTRA_OFF);
  const bool isq = u < 8;
  {
    int r = tid >> 1, part = tid & 1;
    const bf16_t* row = p.proj + (size_t)(m0 + r) * IN_COLS + (isq ? C_QLAT : C_KVLAT);
    int n = isq ? Q_LORA / 2 : KV_LORA / 2;
    const u32x4* src = (const u32x4*)(row + part * n);
    float ss = 0.f;
    for (int i = 0; i < n / 8; ++i) {
      u32x4 v = src[i];
#pragma unroll
      for (int e = 0; e < 4; ++e) {
        float a = __uint_as_float(v[e] << 16), b2 = __uint_as_float(v[e] & 0xffff0000u);
        ss += a * a + b2 * b2;
      }
    }
    ss += __shfl_xor(ss, 1);
    __syncthreads();
    if (part == 0) rs[r] = rsqrtf(ss / (float)(isq ? Q_LORA : KV_LORA) + EPS);
  }
  const int b = m0 / SEQ;
  if (isq) {
    const int hh = u;
    gemm128(p.proj + C_QLAT, IN_COLS, nullptr, m0, p.wq_t, Q_LORA, hh * 96, Q_LORA, smem, [&](int half, const float* sC) {
      const int l16 = tid & 15, c8 = l16 * 8;
#pragma unroll
      for (int pass = 0; pass < 4; ++pass) {
        int r = pass * 16 + (tid >> 4);
        int rg = half * 64 + r;
        float v[8];
        float rl = rs[rg];
        const float* src = sC + r * SC_LD + c8;
        float ss = 0.f;
#pragma unroll
        for (int e = 0; e < 8; ++e) { v[e] = (l16 < 12) ? src[e] * rl : 0.f; ss += v[e] * v[e]; }
        ss += __shfl_xor(ss, 1); ss += __shfl_xor(ss, 2); ss += __shfl_xor(ss, 4); ss += __shfl_xor(ss, 8);
        float rstd = rsqrtf(ss * (1.f / 96.f) + EPS);
        int tok = m0 + rg;
        const float* cs = p.cs + (size_t)tok * 32;
        int gi = (l16 < 12) ? c8 : 0;
#pragma unroll
        for (int e = 0; e < 8; ++e) v[e] = v[e] * rstd * p.qn_g[gi + e];
        float o[8];
#pragma unroll
        for (int e = 0; e < 8; ++e) {
          float other = __shfl_xor(v[e], 2);
          int i = (l16 & 1) * 8 + e;
          float cv = cs[i], sv = cs[16 + i];
          float roped = (l16 < 10) ? (v[e] * cv - other * sv) : (v[e] * cv + other * sv);
          o[e] = (l16 >= 8) ? roped : v[e];
        }
        if (l16 < 12) {
          int sidx = tok - b * SEQ;
          bf16_t* dst = p.Q + ((size_t)(b * MLA_HEADS + hh) * SEQ + sidx) * 96 + c8;
          u32x4 ov = {pack2bf(o[0], o[1]), pack2bf(o[2], o[3]), pack2bf(o[4], o[5]), pack2bf(o[6], o[7])};
          *(u32x4*)dst = ov;
        }
      }
    });
  } else {
    const int hh = u - 8;
    gemm128(p.proj + C_KVLAT, IN_COLS, nullptr, m0, p.wkv_t, KV_LORA, hh * 128, KV_LORA, smem, [&](int half, const float* sC) {
      const int l16 = tid & 15, c8 = l16 * 8;
#pragma unroll
      for (int pass = 0; pass < 4; ++pass) {
        int r = pass * 16 + (tid >> 4);
        int rg = half * 64 + r;
        int tok = m0 + rg;
        float v[8];
        float rl = rs[rg];
        const float* src = sC + r * SC_LD + c8;
#pragma unroll
        for (int e = 0; e < 8; ++e) v[e] = src[e] * rl;
        float kr[8];
        {
          const bf16_t* krp = p.proj + (size_t)tok * IN_COLS + C_KROPE + ((l16 - 8) & 3) * 8;
          u32x4 kv = *(const u32x4*)krp;
#pragma unroll
          for (int e = 0; e < 4; ++e) { kr[2 * e] = __uint_as_float(kv[e] << 16); kr[2 * e + 1] = __uint_as_float(kv[e] & 0xffff0000u); }
        }
        const bool has_nope = l16 < 8, has_rope = (l16 >= 8 && l16 < 12);
        float ss = 0.f;
#pragma unroll
        for (int e = 0; e < 8; ++e) ss += has_nope ? v[e] * v[e] : (has_rope ? kr[e] * kr[e] : 0.f);
        ss += __shfl_xor(ss, 1); ss += __shfl_xor(ss, 2); ss += __shfl_xor(ss, 4); ss += __shfl_xor(ss, 8);
        float rstd = rsqrtf(ss * (1.f / 96.f) + EPS);
        const float* cs = p.cs + (size_t)tok * 32;
        int sidx = tok - b * SEQ;
        size_t orow = (size_t)(b * MLA_HEADS + hh) * SEQ + sidx;
        if (has_nope) {
          float o[8];
#pragma unroll
          for (int e = 0; e < 8; ++e) o[e] = v[e] * rstd * p.kn_g[c8 + e];
          u32x4 ov = {pack2bf(o[0], o[1]), pack2bf(o[2], o[3]), pack2bf(o[4], o[5]), pack2bf(o[6], o[7])};
          *(u32x4*)(p.Kk + orow * 96 + c8) = ov;
        }
        {
          float kn[8], o[8];
          int d0 = ((l16 - 8) & 3) * 8;
#pragma unroll
          for (int e = 0; e < 8; ++e) kn[e] = kr[e] * rstd * p.kn_g[64 + d0 + e];
#pragma unroll
          for (int e = 0; e < 8; ++e) {
            float other = __shfl_xor(kn[e], 2);
            int i = (l16 & 1) * 8 + e;
            float cv = cs[i], sv = cs[16 + i];
            o[e] = (l16 < 10) ? (kn[e] * cv - other * sv) : (kn[e] * cv + other * sv);
          }
          if (has_rope) {
            u32x4 ov = {pack2bf(o[0], o[1]), pack2bf(o[2], o[3]), pack2bf(o[4], o[5]), pack2bf(o[6], o[7])};
            *(u32x4*)(p.Kk + orow * 96 + 64 + d0) = ov;
          }
        }
      }
      {
        int vv = tid & 63, q4 = tid >> 6;
        float t16[16];
#pragma unroll
        for (int e = 0; e < 16; ++e) t16[e] = sC[(q4 * 16 + e) * SC_LD + 64 + vv] * rs[half * 64 + q4 * 16 + e];
        int sidx0 = m0 - b * SEQ + half * 64 + q4 * 16;
        bf16_t* dst = p.V + ((size_t)(b * MLA_HEADS + hh) * 64 + vv) * SEQ + sidx0;
        u32x4 o0 = {pack2bf(t16[0], t16[1]), pack2bf(t16[2], t16[3]), pack2bf(t16[4], t16[5]), pack2bf(t16[6], t16[7])};
        u32x4 o1 = {pack2bf(t16[8], t16[9]), pack2bf(t16[10], t16[11]), pack2bf(t16[12], t16[13]), pack2bf(t16[14], t16[15])};
        *(u32x4*)dst = o0;
        *(u32x4*)(dst + 8) = o1;
      }
    });
  }
}
__global__ void __launch_bounds__(256, 2) k_mla_up_mfma(Params p) {
  __shared__ __attribute__((aligned(16))) char smem[SMEM_TOTAL];
  for (int t = blockIdx.x; t < (NTOK / 128) * 16; t += gridDim.x) mla_up_tile(p, t, smem);
}

using f32x16 = __attribute__((ext_vector_type(16))) float;
using s16x4 = __attribute__((ext_vector_type(4))) short;
using u32x2 = __attribute__((ext_vector_type(2))) unsigned;
#define ATT_KLD 208
#define ATT_VLD 136
#define ATT_VOFF (64 * ATT_KLD)
#define MFMA32(a, b, c) __builtin_amdgcn_mfma_f32_32x32x16_bf16((a), (b), (c), 0, 0, 0)

__device__ __forceinline__ void attn_item(const Params& p, int item, char* smem) {
  int tid_ = threadIdx.x;
  asm volatile("" : "+v"(tid_));
  const int tid = tid_, lane = tid & 63, w = tid >> 6, r = lane & 31, h = lane >> 5;
  const int bh = item >> 4, qb = item & 15;
  char* sK = smem;
  char* sV = smem + ATT_VOFF;
  const bf16_t* Qp = p.Q + ((size_t)bh * SEQ + qb * 128 + w * 32 + r) * 96;
  const char* Kp = (const char*)(p.Kk + (size_t)bh * SEQ * 96);
  const char* Vp = (const char*)(p.V + (size_t)bh * 64 * SEQ);
  bf16x8 qf[6];
#pragma unroll
  for (int ks = 0; ks < 6; ++ks) qf[ks] = *(const bf16x8*)(Qp + ks * 16 + h * 8);
  f32x16 o0, o1;
#pragma unroll
  for (int i = 0; i < 16; ++i) { o0[i] = 0.f; o1[i] = 0.f; }
  float m = -1e30f, l = 0.f;
  const float c = 0.10206207261596577f * 1.4426950408889634f;
  int kgo[3], klo[3], vgo[2], vlo[2];
#pragma unroll
  for (int i = 0; i < 3; ++i) { int cc = tid + 256 * i, row = cc / 12, ch = cc % 12; kgo[i] = cc * 16; klo[i] = row * ATT_KLD + ch * 16; }
#pragma unroll
  for (int i = 0; i < 2; ++i) { int cc = tid + 256 * i, vr = cc >> 3, ch = cc & 7; vgo[i] = vr * (SEQ * 2) + ch * 16; vlo[i] = vr * ATT_VLD + ch * 16; }
  u32x4 rk[3], rv[2];
#pragma unroll
  for (int i = 0; i < 3; ++i) rk[i] = *(const u32x4*)(Kp + kgo[i]);
#pragma unroll
  for (int i = 0; i < 2; ++i) rv[i] = *(const u32x4*)(Vp + vgo[i]);

  auto stage_store = [&]() {
#pragma unroll
    for (int i = 0; i < 3; ++i) *(u32x4*)(sK + klo[i]) = rk[i];
#pragma unroll
    for (int i = 0; i < 2; ++i) {
      u32x2 lo = {rv[i][0], rv[i][1]}, hi = {rv[i][2], rv[i][3]};
      *(u32x2*)(sV + vlo[i]) = lo;
      *(u32x2*)(sV + vlo[i] + 8) = hi;
    }
  };
  auto compute = [&]() {
    f32x16 s0, s1;
#pragma unroll
    for (int i = 0; i < 16; ++i) { s0[i] = 0.f; s1[i] = 0.f; }
#pragma unroll
    for (int ks = 0; ks < 6; ++ks) {
      bf16x8 a0 = *(const bf16x8*)(sK + r * ATT_KLD + (ks * 2 + h) * 16);
      bf16x8 a1 = *(const bf16x8*)(sK + (32 + r) * ATT_KLD + (ks * 2 + h) * 16);
      s0 = MFMA32(a0, qf[ks], s0);
      s1 = MFMA32(a1, qf[ks], s1);
    }
    float mx = s0[0];
#pragma unroll
    for (int i = 1; i < 16; ++i) mx = fmaxf(mx, s0[i]);
#pragma unroll
    for (int i = 0; i < 16; ++i) mx = fmaxf(mx, s1[i]);
    mx = fmaxf(mx, __shfl_xor(mx, 32));
    float mn = fmaxf(m, mx);
    float alpha = exp2f((m - mn) * c);
    m = mn;
    float mc = mn * c;
    float ls = 0.f;
#pragma unroll
    for (int i = 0; i < 16; ++i) { s0[i] = exp2f(s0[i] * c - mc); ls += s0[i]; }
#pragma unroll
    for (int i = 0; i < 16; ++i) { s1[i] = exp2f(s1[i] * c - mc); ls += s1[i]; }
    l = l * alpha + ls;
#pragma unroll
    for (int i = 0; i < 16; ++i) { o0[i] *= alpha; o1[i] *= alpha; }
#pragma unroll
    for (int kb = 0; kb < 2; ++kb) {
#pragma unroll
      for (int s = 0; s < 2; ++s) {
        u32x4 pk;
#pragma unroll
        for (int e = 0; e < 4; ++e) {
          float a = kb ? s1[8 * s + 2 * e] : s0[8 * s + 2 * e];
          float b2 = kb ? s1[8 * s + 2 * e + 1] : s0[8 * s + 2 * e + 1];
          pk[e] = pack2bf(a, b2);
        }
        bf16x8 pf = __builtin_bit_cast(bf16x8, pk);
        int koff = (kb * 32 + 16 * s + 4 * h) * 2;
        s16x4 lo0 = *(const s16x4*)(sV + r * ATT_VLD + koff);
        s16x4 hi0 = *(const s16x4*)(sV + r * ATT_VLD + koff + 16);
        s16x4 lo1 = *(const s16x4*)(sV + (32 + r) * ATT_VLD + koff);
        s16x4 hi1 = *(const s16x4*)(sV + (32 + r) * ATT_VLD + koff + 16);
        bf16x8 v0 = __builtin_shufflevector(lo0, hi0, 0, 1, 2, 3, 4, 5, 6, 7);
        bf16x8 v1 = __builtin_shufflevector(lo1, hi1, 0, 1, 2, 3, 4, 5, 6, 7);
        o0 = MFMA32(v0, pf, o0);
        o1 = MFMA32(v1, pf, o1);
      }
    }
  };
  for (int kt = 1; kt < SEQ / 64; ++kt) {
    __syncthreads();
    stage_store();
    __syncthreads();
#pragma unroll
    for (int i = 0; i < 3; ++i) rk[i] = *(const u32x4*)(Kp + (size_t)kt * (64 * 192) + kgo[i]);
#pragma unroll
    for (int i = 0; i < 2; ++i) rv[i] = *(const u32x4*)(Vp + kt * 128 + vgo[i]);
    compute();
  }
  __syncthreads();
  stage_store();
  __syncthreads();
  compute();
  l += __shfl_xor(l, 32);
  float inv = 1.f / l;
  const int b = bh >> 3, hh = bh & 7;
  bf16_t* orow = p.mix + ((size_t)b * SEQ + qb * 128 + w * 32 + r) * D_MODEL + hh * 64;
#pragma unroll
  for (int g = 0; g < 4; ++g) {
    u32x2 w0 = {pack2bf(o0[4 * g] * inv, o0[4 * g + 1] * inv), pack2bf(o0[4 * g + 2] * inv, o0[4 * g + 3] * inv)};
    u32x2 w1 = {pack2bf(o1[4 * g] * inv, o1[4 * g + 1] * inv), pack2bf(o1[4 * g + 2] * inv, o1[4 * g + 3] * inv)};
    *(u32x2*)(orow + 8 * g + 4 * h) = w0;
    *(u32x2*)(orow + 32 + 8 * g + 4 * h) = w1;
  }
}
__global__ void __launch_bounds__(256, 2) k_attn_mfma(Params p) {
  __shared__ __attribute__((aligned(16))) char smem[SMEM_TOTAL];
  for (int it = blockIdx.x; it < BATCH * MLA_HEADS * 16; it += gridDim.x) attn_item(p, it, smem);
}

#define HG_QD 0
#define HG_KD 17408
#define HG_KRT 34816
#define HG_VT 53248
#define HG_DL 71680
#define HG_PRE 72192
#define HG_SMEM 73216
#define HG_OT 0

__device__ __forceinline__ void hgrn_item(const Params& p, int item, char* smem) {
  const int DIR = item & 1, hh = (item >> 1) & 3, b = item >> 3;
  __syncthreads();
  int tid_ = threadIdx.x;
  asm volatile("" : "+v"(tid_));
  const int tid = tid_, lane = tid & 63, w = tid >> 6, r = lane & 31, h = lane >> 5;
  char* sQD = smem + HG_QD; char* sKD = smem + HG_KD; char* sKRT = smem + HG_KRT; char* sVT = smem + HG_VT;
  float* dl = (float*)(smem + HG_DL); float* pre = (float*)(smem + HG_PRE); float* sOT = (float*)(smem + HG_OT);
  f32x16 S[4];
#pragma unroll
  for (int kt = 0; kt < 4; ++kt)
#pragma unroll
    for (int i = 0; i < 16; ++i) S[kt][i] = 0.f;
  const int k = tid & 127, part = tid >> 7;
  const int fcol = DIR ? C_HFB : C_HFF;
  const float lbv = p.lb[DIR * HG_W + hh * 128 + k];
  bf16_t* odir = p.of16 + (size_t)DIR * NTOK * HG_W;
  const bf16_t* hiT_bh = p.hiT + (size_t)(b * HG_HEADS + hh) * HG_DIM * SEQ;
  for (int n = 0; n < SEQ / 64; ++n) {
    const int cn = DIR ? (SEQ / 64 - 1 - n) : n;
    const size_t tok0 = (size_t)b * SEQ + cn * 64;
#pragma unroll
    for (int i = 0; i < 4; ++i) {
      int cc = tid + 256 * i, c = cc >> 4, ch = cc & 15;
      const bf16_t* rowp = p.proj + (tok0 + c) * IN_COLS + hh * 128 + ch * 8;
      *(u32x4*)(sQD + c * 272 + ch * 16) = *(const u32x4*)(rowp + C_HQ);
      *(u32x4*)(sKD + c * 272 + ch * 16) = *(const u32x4*)(rowp + fcol);
      int v = cc >> 3, ch8 = cc & 7;
      *(u32x4*)(sVT + v * 144 + ch8 * 16) = *(const u32x4*)(hiT_bh + (size_t)v * SEQ + cn * 64 + ch8 * 8);
    }
    unsigned pf0 = 0, pf1 = 0;
    if (n + 1 < SEQ / 64) {
      const int cn2 = DIR ? cn - 1 : cn + 1;
      const size_t tokn = (size_t)b * SEQ + cn2 * 64;
      const int c = tid >> 2, sub = tid & 3;
      pf0 = *(const unsigned*)(p.proj + (tokn + c) * IN_COLS + hh * 128 + ((sub & 2) ? fcol : C_HQ) + (sub & 1) * 64);
      if (tid < 128) pf1 = *(const unsigned*)(hiT_bh + (size_t)tid * SEQ + cn2 * 64);
    }
    __syncthreads();
    {
      const float L2E = 1.4426950408889634f;
      const float oml = 1.f - lbv;
      float lf[32];
#pragma unroll
      for (int i = 0; i < 32; i += 2) {
        bf16_t* zp0 = (bf16_t*)(sKD + (32 * part + i) * 272 + k * 2);
        bf16_t* zp1 = (bf16_t*)(sKD + (32 * part + i + 1) * 272 + k * 2);
        float z0 = bf2f(*zp0), z1 = bf2f(*zp1);
        float om0 = oml * __builtin_amdgcn_rcpf(1.f + __builtin_amdgcn_exp2f(z0 * L2E));
        float om1 = oml * __builtin_amdgcn_rcpf(1.f + __builtin_amdgcn_exp2f(z1 * L2E));
        lf[i] = __builtin_amdgcn_logf(1.f - om0);
        lf[i + 1] = __builtin_amdgcn_logf(1.f - om1);
        unsigned pk = pack2bf(om0, om1);
        *zp0 = (bf16_t)(pk & 0xffffu);
        *zp1 = (bf16_t)(pk >> 16);
      }
      if (DIR == 0) {
#pragma unroll
        for (int i = 1; i < 32; ++i) lf[i] += lf[i - 1];
      } else {
#pragma unroll
        for (int i = 30; i >= 0; --i) lf[i] += lf[i + 1];
      }
      const float tot = DIR ? lf[0] : lf[31];
      pre[part * 128 + k] = tot;
      __syncthreads();
      const float other = pre[(part ^ 1) * 128 + k];
      const float btot = tot + other;
      const float off = (DIR == 0) ? (part == 1 ? other : 0.f) : (part == 0 ? other : 0.f);
      const float ebtot = __builtin_amdgcn_exp2f(btot);
      if (part == 0) dl[k] = ebtot;
#pragma unroll
      for (int q = 0; q < 4; ++q) {
        float kr8[8];
#pragma unroll
        for (int u = 0; u < 8; u += 2) {
          const int i = q * 8 + u, c = 32 * part + i;
          bf16_t* kp0 = (bf16_t*)(sKD + c * 272 + k * 2);
          bf16_t* kp1 = (bf16_t*)(sKD + (c + 1) * 272 + k * 2);
          bf16_t* qp0 = (bf16_t*)(sQD + c * 272 + k * 2);
          bf16_t* qp1 = (bf16_t*)(sQD + (c + 1) * 272 + k * 2);
          float kk0 = bf2f(*kp0), kk1 = bf2f(*kp1), zq0 = bf2f(*qp0), zq1 = bf2f(*qp1);
          float bb0 = lf[i] + off, bb1 = lf[i + 1] + off;
          float eb0 = __builtin_amdgcn_exp2f(bb0), eb1 = __builtin_amdgcn_exp2f(bb1);
          float kd0 = kk0 * __builtin_amdgcn_exp2f(-bb0), kd1 = kk1 * __builtin_amdgcn_exp2f(-bb1);
          float qd0 = zq0 * __builtin_amdgcn_rcpf(1.f + __builtin_amdgcn_exp2f(-zq0 * L2E)) * eb0;
          float qd1 = zq1 * __builtin_amdgcn_rcpf(1.f + __builtin_amdgcn_exp2f(-zq1 * L2E)) * eb1;
          kr8[u] = kd0 * ebtot; kr8[u + 1] = kd1 * ebtot;
          unsigned pq = pack2bf(qd0, qd1), pk2 = pack2bf(kd0, kd1);
          *qp0 = (bf16_t)(pq & 0xffffu); *qp1 = (bf16_t)(pq >> 16);
          *kp0 = (bf16_t)(pk2 & 0xffffu); *kp1 = (bf16_t)(pk2 >> 16);
        }
        u32x4 o = {pack2bf(kr8[0], kr8[1]), pack2bf(kr8[2], kr8[3]), pack2bf(kr8[4], kr8[5]), pack2bf(kr8[6], kr8[7])};
        *(u32x4*)(sKRT + k * 144 + part * 64 + q * 16) = o;
      }
    }
    __syncthreads();
    {
      const int cb = w >> 1, sb = w & 1;
      const bool skip = DIR ? (cb == 1 && sb == 0) : (cb == 0 && sb == 1);
      f32x16 acc;
#pragma unroll
      for (int i = 0; i < 16; ++i) acc[i] = 0.f;
      if (!skip) {
#pragma unroll
        for (int ks = 0; ks < 8; ++ks) {
          bf16x8 a = *(const bf16x8*)(sQD + (cb * 32 + r) * 272 + (ks * 2 + h) * 16);
          bf16x8 bb = *(const bf16x8*)(sKD + (sb * 32 + r) * 272 + (ks * 2 + h) * 16);
          acc = MFMA32(a, bb, acc);
        }
      }
      __syncthreads();
#pragma unroll
      for (int i = 0; i < 16; ++i) {
        int c = cb * 32 + (i & 3) + 8 * (i >> 2) + 4 * h, s = sb * 32 + r;
        bool keep = DIR ? (s >= c) : (s <= c);
        *(bf16_t*)(sKD + c * 144 + s * 2) = f2bf(keep ? acc[i] : 0.f);
      }
    }
    __syncthreads();
    f32x16 oc[2];
#pragma unroll
    for (int cb = 0; cb < 2; ++cb)
#pragma unroll
      for (int i = 0; i < 16; ++i) oc[cb][i] = 0.f;
#pragma unroll
    for (int kt = 0; kt < 4; ++kt) {
#pragma unroll
      for (int s = 0; s < 2; ++s) {
        u32x4 pk;
#pragma unroll
        for (int e = 0; e < 4; ++e) pk[e] = pack2bf(S[kt][8 * s + 2 * e], S[kt][8 * s + 2 * e + 1]);
        bf16x8 pf = __builtin_bit_cast(bf16x8, pk);
        int kof = (kt * 32 + 16 * s + 4 * h) * 2;
#pragma unroll
        for (int cb = 0; cb < 2; ++cb) {
          s16x4 lo = *(const s16x4*)(sQD + (cb * 32 + r) * 272 + kof);
          s16x4 hi = *(const s16x4*)(sQD + (cb * 32 + r) * 272 + kof + 16);
          bf16x8 a = __builtin_shufflevector(lo, hi, 0, 1, 2, 3, 4, 5, 6, 7);
          oc[cb] = MFMA32(a, pf, oc[cb]);
        }
      }
    }
#pragma unroll
    for (int st = 0; st < 4; ++st) {
      bf16x8 bv = *(const bf16x8*)(sVT + (w * 32 + r) * 144 + (st * 2 + h) * 16);
#pragma unroll
      for (int cb = 0; cb < 2; ++cb) {
        bf16x8 a = *(const bf16x8*)(sKD + (cb * 32 + r) * 144 + (st * 2 + h) * 16);
        oc[cb] = MFMA32(a, bv, oc[cb]);
      }
    }
#pragma unroll
    for (int kt = 0; kt < 4; ++kt) {
#pragma unroll
      for (int g = 0; g < 4; ++g) {
        float4 d4 = *(const float4*)(dl + kt * 32 + 8 * g + 4 * h);
        S[kt][4 * g] *= d4.x; S[kt][4 * g + 1] *= d4.y; S[kt][4 * g + 2] *= d4.z; S[kt][4 * g + 3] *= d4.w;
      }
#pragma unroll
      for (int st = 0; st < 4; ++st) {
        bf16x8 a = *(const bf16x8*)(sKRT + (kt * 32 + r) * 144 + (st * 2 + h) * 16);
        bf16x8 bv = *(const bf16x8*)(sVT + (w * 32 + r) * 144 + (st * 2 + h) * 16);
        S[kt] = MFMA32(a, bv, S[kt]);
      }
    }
    __syncthreads();
#pragma unroll
    for (int cb = 0; cb < 2; ++cb)
#pragma unroll
      for (int i = 0; i < 16; ++i) sOT[(cb * 32 + (i & 3) + 8 * (i >> 2) + 4 * h) * 132 + w * 32 + r] = oc[cb][i];
    __syncthreads();
    {
      const int c = tid >> 2, qd = tid & 3;
      const float* src = sOT + c * 132 + qd * 32;
      bf16_t* ofp = odir + (tok0 + c) * HG_W + hh * 128 + qd * 32;
#pragma unroll
      for (int q = 0; q < 4; ++q) {
        float4 v0 = *(const float4*)(src + q * 8), v1 = *(const float4*)(src + q * 8 + 4);
        u32x4 o = {pack2bf(v0.x, v0.y), pack2bf(v0.z, v0.w), pack2bf(v1.x, v1.y), pack2bf(v1.z, v1.w)};
        *(u32x4*)(ofp + q * 8) = o;
      }
    }
    if (pf0 == 0x7fc12345u && pf1 == 0x7fc54321u) p.qctr[3] = 1;
    __syncthreads();
  }
  asm volatile("s_waitcnt vmcnt(0)" ::: "memory");
  __syncthreads();
  int* tk = (int*)(smem + HG_PRE);
  if (tid == 0) {
    __builtin_amdgcn_fence(__ATOMIC_RELEASE, "agent");
    asm volatile("s_waitcnt vmcnt(0)" ::: "memory");
    int old = __hip_atomic_fetch_add(&p.hcnt[b * HG_HEADS + hh], 1, __ATOMIC_RELAXED, __HIP_MEMORY_SCOPE_AGENT);
    if (old == 1) {
      __builtin_amdgcn_fence(__ATOMIC_ACQUIRE, "agent");
      asm volatile("s_waitcnt vmcnt(0)" ::: "memory");
    }
    *tk = old;
  }
  __syncthreads();
  if (*tk == 1) {
    const int qd = tid & 3;
    const float4* ngp = (const float4*)(p.hg_norm_g + qd * 32);
    for (int pass = 0; pass < SEQ / 64; ++pass) {
      const size_t tok = (size_t)b * SEQ + pass * 64 + (tid >> 2);
      const bf16_t* f0 = p.of16 + tok * HG_W + hh * 128 + qd * 32;
      const bf16_t* f1 = f0 + (size_t)NTOK * HG_W;
      const bf16_t* hgp = p.proj + tok * IN_COLS + C_HG + hh * 128 + qd * 32;
      u32x4 a4[4], b4[4], g4[4];
#pragma unroll
      for (int q = 0; q < 4; ++q) { a4[q] = *(const u32x4*)(f0 + q * 8); b4[q] = *(const u32x4*)(f1 + q * 8); g4[q] = *(const u32x4*)(hgp + q * 8); }
      float ov[32];
      float ss = 0.f;
#pragma unroll
      for (int q = 0; q < 4; ++q)
#pragma unroll
        for (int e = 0; e < 4; ++e) {
          float lo = __uint_as_float(a4[q][e] << 16) + __uint_as_float(b4[q][e] << 16);
          float hi = __uint_as_float(a4[q][e] & 0xffff0000u) + __uint_as_float(b4[q][e] & 0xffff0000u);
          ov[q * 8 + 2 * e] = lo; ov[q * 8 + 2 * e + 1] = hi;
          ss += lo * lo + hi * hi;
        }
      ss += __shfl_xor(ss, 1); ss += __shfl_xor(ss, 2);
      const float rstd = rsqrtf(ss * (1.f / 128.f) + EPS);
      bf16_t* dst = p.mix + tok * D_MODEL + 512 + hh * 128 + qd * 32;
#pragma unroll
      for (int q = 0; q < 4; ++q) {
        float4 n0 = ngp[q * 2], n1 = ngp[q * 2 + 1];
        float ng[8] = {n0.x, n0.y, n0.z, n0.w, n1.x, n1.y, n1.z, n1.w};
        float res[8];
#pragma unroll
        for (int e = 0; e < 4; ++e) {
          float g0 = __uint_as_float(g4[q][e] << 16), g1 = __uint_as_float(g4[q][e] & 0xffff0000u);
          res[2 * e] = ov[q * 8 + 2 * e] * rstd * ng[2 * e] * silu_f(g0);
          res[2 * e + 1] = ov[q * 8 + 2 * e + 1] * rstd * ng[2 * e + 1] * silu_f(g1);
        }
        u32x4 o = {pack2bf(res[0], res[1]), pack2bf(res[2], res[3]), pack2bf(res[4], res[5]), pack2bf(res[6], res[7])};
        *(u32x4*)(dst + q * 8) = o;
      }
    }
  }
}
__global__ void __launch_bounds__(256, 2) k_hgrn_mfma(Params p) {
  __shared__ __attribute__((aligned(16))) char smem[HG_SMEM];
  for (int it = blockIdx.x; it < BATCH * HG_HEADS * 2; it += gridDim.x) hgrn_item(p, it, smem);
}

__global__ void __launch_bounds__(256) k_gemm_proj(Params p) {
  __shared__ GemmSmem s;
  int m0 = blockIdx.y * 64, n0 = blockIdx.x * 64;
  bf16_t* C = p.proj;
  gemm_tile_naive(p.h, D_MODEL, nullptr, p.w_in, IN_COLS, D_MODEL, m0, n0, IN_COLS, s,
                  [=](int r, int n, float v) { C[(size_t)(m0 + r) * IN_COLS + n] = f2bf(v); });
}

__global__ void __launch_bounds__(256) k_lat_norm(Params p) {
  int t = blockIdx.x * 4 + (threadIdx.x >> 6), lane = threadIdx.x & 63;
  bf16_t* row = p.proj + (size_t)t * IN_COLS;
  float q[6], ss = 0.f;
#pragma unroll
  for (int j = 0; j < 6; ++j) { q[j] = bf2f(row[C_QLAT + lane + 64 * j]); ss += q[j] * q[j]; }
  ss = wave_sum(ss);
  float rstd = rsqrtf(ss * (1.f / Q_LORA) + EPS);
#pragma unroll
  for (int j = 0; j < 6; ++j) row[C_QLAT + lane + 64 * j] = f2bf(q[j] * rstd * p.qa_g[lane + 64 * j]);
  float kv[4]; ss = 0.f;
#pragma unroll
  for (int j = 0; j < 4; ++j) { kv[j] = bf2f(row[C_KVLAT + lane + 64 * j]); ss += kv[j] * kv[j]; }
  ss = wave_sum(ss);
  rstd = rsqrtf(ss * (1.f / KV_LORA) + EPS);
#pragma unroll
  for (int j = 0; j < 4; ++j) row[C_KVLAT + lane + 64 * j] = f2bf(kv[j] * rstd * p.kva_g[lane + 64 * j]);
}

__global__ void __launch_bounds__(256) k_gemm_up(Params p) {
  __shared__ GemmSmem s;
  int m0 = blockIdx.y * 64;
  int nb = blockIdx.x;
  bf16_t* C = p.qkv_raw;
  if (nb < 12) {
    int n0 = nb * 64;
    gemm_tile_naive(p.proj + C_QLAT, IN_COLS, nullptr, p.wq_up, 768, Q_LORA, m0, n0, 768, s,
                    [=](int r, int n, float v) { C[(size_t)(m0 + r) * 1792 + n] = f2bf(v); });
  } else {
    int n0 = (nb - 12) * 64;
    gemm_tile_naive(p.proj + C_KVLAT, IN_COLS, nullptr, p.wkv_up, 1024, KV_LORA, m0, n0, 1024, s,
                    [=](int r, int n, float v) { C[(size_t)(m0 + r) * 1792 + 768 + n] = f2bf(v); });
  }
}

__global__ void __launch_bounds__(256) k_qkv_post(Params p) {
  int gw = blockIdx.x * 4 + (threadIdx.x >> 6), lane = threadIdx.x & 63;
  int t = gw >> 3, hh = gw & 7;
  int b = t / SEQ, sidx = t % SEQ;
  const bf16_t* raw = p.qkv_raw + (size_t)t * 1792;
  const float* cs = p.cs + t * 32;
  size_t orow = ((size_t)(b * MLA_HEADS + hh) * SEQ + sidx);
  {
    float a = bf2f(raw[hh * 96 + lane]);
    float c2 = (lane < 32) ? bf2f(raw[hh * 96 + 64 + lane]) : 0.f;
    float ss = wave_sum(a * a + c2 * c2);
    float rstd = rsqrtf(ss * (1.f / 96.f) + EPS);
    a = a * rstd * p.qn_g[lane];
    c2 = (lane < 32) ? c2 * rstd * p.qn_g[64 + lane] : 0.f;
    float other = __shfl_xor(c2, 16);
    int i = lane & 15;
    float cv = cs[i], sv = cs[16 + i];
    float r = (lane < 16) ? (c2 * cv - other * sv) : (c2 * cv + other * sv);
    bf16_t* q = p.Q + orow * 96;
    q[lane] = f2bf(a);
    if (lane < 32) q[64 + lane] = f2bf(r);
  }
  {
    float a = bf2f(raw[768 + hh * 128 + lane]);
    float c2 = (lane < 32) ? bf2f(p.proj[(size_t)t * IN_COLS + C_KROPE + lane]) : 0.f;
    float ss = wave_sum(a * a + c2 * c2);
    float rstd = rsqrtf(ss * (1.f / 96.f) + EPS);
    a = a * rstd * p.kn_g[lane];
    c2 = (lane < 32) ? c2 * rstd * p.kn_g[64 + lane] : 0.f;
    float other = __shfl_xor(c2, 16);
    int i = lane & 15;
    float cv = cs[i], sv = cs[16 + i];
    float r = (lane < 16) ? (c2 * cv - other * sv) : (c2 * cv + other * sv);
    bf16_t* k = p.Kk + orow * 96;
    k[lane] = f2bf(a);
    if (lane < 32) k[64 + lane] = f2bf(r);
    p.V[orow * 64 + lane] = raw[768 + hh * 128 + 64 + lane];
  }
}

__global__ void __launch_bounds__(256) k_attn_naive(Params p) {
  __shared__ float sq[4][96];
  __shared__ float sc[4][SEQ];
  int blk = blockIdx.x;
  int qb = blk % (SEQ / 4), bh = blk / (SEQ / 4);
  int tid = threadIdx.x, w = tid >> 6, lane = tid & 63;
  const bf16_t* Qp = p.Q + ((size_t)bh * SEQ + qb * 4) * 96;
  const bf16_t* Kp = p.Kk + (size_t)bh * SEQ * 96;
  const bf16_t* Vp = p.V + (size_t)bh * SEQ * 64;
  for (int i = tid; i < 4 * 96; i += 256) sq[i / 96][i % 96] = bf2f(Qp[i]);
  __syncthreads();
  const float scale = 0.10206207261596577f;
  for (int j = tid; j < SEQ; j += 256) {
    const uint4* kr = (const uint4*)(Kp + (size_t)j * 96);
    float a0 = 0.f, a1 = 0.f, a2 = 0.f, a3 = 0.f;
#pragma unroll
    for (int c = 0; c < 12; ++c) {
      uint4 u = kr[c];
      unsigned uu[4] = {u.x, u.y, u.z, u.w};
#pragma unroll
      for (int e = 0; e < 4; ++e) {
        float k0 = __uint_as_float(uu[e] << 16), k1 = __uint_as_float(uu[e] & 0xffff0000u);
        int d = c * 8 + e * 2;
        a0 += sq[0][d] * k0 + sq[0][d + 1] * k1;
        a1 += sq[1][d] * k0 + sq[1][d + 1] * k1;
        a2 += sq[2][d] * k0 + sq[2][d + 1] * k1;
        a3 += sq[3][d] * k0 + sq[3][d + 1] * k1;
      }
    }
    sc[0][j] = a0 * scale; sc[1][j] = a1 * scale; sc[2][j] = a2 * scale; sc[3][j] = a3 * scale;
  }
  __syncthreads();
  float m = -1e30f;
  for (int j = lane; j < SEQ; j += 64) m = fmaxf(m, sc[w][j]);
  m = wave_max(m);
  float sum = 0.f;
  for (int j = lane; j < SEQ; j += 64) { float e = __expf(sc[w][j] - m); sc[w][j] = e; sum += e; }
  sum = wave_sum(sum);
  __syncthreads();
  float acc = 0.f;
  for (int j = 0; j < SEQ; ++j) acc += sc[w][j] * bf2f(Vp[(size_t)j * 64 + lane]);
  acc /= sum;
  int b = bh / MLA_HEADS, hh = bh % MLA_HEADS;
  int t = b * SEQ + qb * 4 + w;
  p.mix[(size_t)t * D_MODEL + hh * 64 + lane] = f2bf(acc);
}

__global__ void __launch_bounds__(64) k_hgrn_naive(Params p) {
  __shared__ float sq[2][128], sf[2][128], sk[2][128];
  int blk = blockIdx.x;
  int vh = blk & 1, dir = (blk >> 1) & 1, hh = (blk >> 2) & 3, b = blk >> 4;
  int lane = threadIdx.x;
  float S[128];
#pragma unroll
  for (int k = 0; k < 128; ++k) S[k] = 0.f;
  const float lb0 = p.lb[dir * HG_W + hh * 128 + lane], lb1 = p.lb[dir * HG_W + hh * 128 + 64 + lane];
  float* outp = dir ? p.o_b : p.o_f;
  const int fcol = dir ? C_HFB : C_HFF;
  for (int step = 0; step < SEQ; ++step) {
    int sidx = dir ? (SEQ - 1 - step) : step;
    size_t t = (size_t)b * SEQ + sidx;
    const bf16_t* row = p.proj + t * IN_COLS;
    int buf = step & 1;
    {
      float z0 = bf2f(row[fcol + hh * 128 + lane]), z1 = bf2f(row[fcol + hh * 128 + 64 + lane]);
      float f0 = lb0 + (1.f - lb0) * sigmoid_f(z0), f1 = lb1 + (1.f - lb1) * sigmoid_f(z1);
      sf[buf][lane] = f0; sf[buf][64 + lane] = f1;
      sk[buf][lane] = 1.f - f0; sk[buf][64 + lane] = 1.f - f1;
      sq[buf][lane] = silu_f(bf2f(row[C_HQ + hh * 128 + lane]));
      sq[buf][64 + lane] = silu_f(bf2f(row[C_HQ + hh * 128 + 64 + lane]));
    }
    float v = bf2f(p.hiT[((size_t)(b * HG_HEADS + hh) * HG_DIM + vh * 64 + lane) * SEQ + sidx]);
    __syncthreads();
    float o = 0.f;
#pragma unroll
    for (int k = 0; k < 128; k += 4) {
      float4 f4 = *(const float4*)&sf[buf][k];
      float4 k4 = *(const float4*)&sk[buf][k];
      float4 q4 = *(const float4*)&sq[buf][k];
      S[k + 0] = f4.x * S[k + 0] + k4.x * v; o += S[k + 0] * q4.x;
      S[k + 1] = f4.y * S[k + 1] + k4.y * v; o += S[k + 1] * q4.y;
      S[k + 2] = f4.z * S[k + 2] + k4.z * v; o += S[k + 2] * q4.z;
      S[k + 3] = f4.w * S[k + 3] + k4.w * v; o += S[k + 3] * q4.w;
    }
    outp[t * HG_W + hh * 128 + vh * 64 + lane] = o;
  }
}

__global__ void __launch_bounds__(256) k_rec_combine(Params p) {
  int gw = blockIdx.x * 4 + (threadIdx.x >> 6), lane = threadIdx.x & 63;
  int t = gw >> 2, hh = gw & 3;
  size_t base = (size_t)t * HG_W + hh * 128;
  float a = p.o_f[base + lane] + p.o_b[base + lane];
  float c2 = p.o_f[base + 64 + lane] + p.o_b[base + 64 + lane];
  float ss = wave_sum(a * a + c2 * c2);
  float rstd = rsqrtf(ss * (1.f / 128.f) + EPS);
  const bf16_t* row = p.proj + (size_t)t * IN_COLS + C_HG + hh * 128;
  float g0 = silu_f(bf2f(row[lane])), g1 = silu_f(bf2f(row[64 + lane]));
  bf16_t* o = p.mix + (size_t)t * D_MODEL + 512 + hh * 128;
  o[lane] = f2bf(a * rstd * p.hg_norm_g[lane] * g0);
  o[64 + lane] = f2bf(c2 * rstd * p.hg_norm_g[64 + lane] * g1);
}

__global__ void __launch_bounds__(256) k_gemm_out(Params p) {
  __shared__ GemmSmem s;
  int m0 = blockIdx.y * 64, n0 = blockIdx.x * 64;
  float* C = p.out; const float* X = p.x; const float* mod = p.mod;
  gemm_tile_naive(p.mix, D_MODEL, nullptr, p.w_out, D_MODEL, D_MODEL, m0, n0, D_MODEL, s,
                  [=](int r, int n, float v) {
                    int m = m0 + r, b = m / SEQ;
                    C[(size_t)m * D_MODEL + n] = X[(size_t)m * D_MODEL + n] + mod[b * 6144 + 2048 + n] * v;
                  });
}

__global__ void __launch_bounds__(256) k_norm2_route(Params p) {
  __shared__ float red[4];
  __shared__ float lg[36][4];
  int t = blockIdx.x, b = t / SEQ, tid = threadIdx.x;
  const float4 xv = ((const float4*)(p.out + (size_t)t * D_MODEL))[tid];
  float ss = xv.x * xv.x + xv.y * xv.y + xv.z * xv.z + xv.w * xv.w;
  ss = block_sum256(ss, red);
  float rstd = rsqrtf(ss * (1.f / D_MODEL) + EPS);
  int c0 = tid * 4;
  const float* shift = p.mod + b * 6144 + 3072, * scale = p.mod + b * 6144 + 4096;
  float v[4] = {xv.x, xv.y, xv.z, xv.w}, hv[4];
  bf16_t o[4];
#pragma unroll
  for (int j = 0; j < 4; ++j) {
    hv[j] = v[j] * rstd * p.norm2_g[c0 + j] * (1.f + scale[c0 + j]) + shift[c0 + j];
    o[j] = f2bf(hv[j]);
  }
  ushort4 ov = {o[0], o[1], o[2], o[3]};
  ((ushort4*)(p.h + (size_t)t * D_MODEL))[tid] = ov;
  for (int e = 0; e < 36; ++e) {
    float a = 0.f;
#pragma unroll
    for (int j = 0; j < 4; ++j) {
      float wv = (e < 4) ? p.rg_w[(c0 + j) * 4 + e] : p.re_w[(c0 + j) * 32 + (e - 4)];
      a += hv[j] * wv;
    }
    a = wave_sum(a);
    if ((tid & 63) == 0) lg[e][tid >> 6] = a;
  }
  __syncthreads();
  if (tid == 0) {
    float gl[4]; int gi = 0; float gm = -1e30f;
    for (int g = 0; g < 4; ++g) {
      gl[g] = lg[g][0] + lg[g][1] + lg[g][2] + lg[g][3] + p.rg_b[g];
      if (gl[g] > gm) { gm = gl[g]; gi = g; }
    }
    float gs = 0.f;
    for (int g = 0; g < 4; ++g) gs += expf(gl[g] - gm);
    float gp = 1.f / gs;
    float v1 = -1e30f, v2 = -1e30f; int i1 = 0, i2 = 0;
    for (int e = 0; e < 8; ++e) {
      int ee = 4 + gi * 8 + e;
      float l = lg[ee][0] + lg[ee][1] + lg[ee][2] + lg[ee][3] + p.re_b[gi * 8 + e];
      if (l > v1) { v2 = v1; i2 = i1; v1 = l; i1 = e; }
      else if (l > v2) { v2 = l; i2 = e; }
    }
    float e2 = expf(v2 - v1);
    float w1 = gp / (1.f + e2), w2 = gp * e2 / (1.f + e2);
    int ex1 = gi * 8 + i1, ex2 = gi * 8 + i2;
    p.eid[t * 2] = ex1; p.eid[t * 2 + 1] = ex2;
    p.ewt[t * 2] = w1; p.ewt[t * 2 + 1] = w2;
    int p1 = atomicAdd(&p.cnt[ex1], 1); p.list[ex1 * 65536 + p1] = t * 2;
    int p2 = atomicAdd(&p.cnt[ex2], 1); p.list[ex2 * 65536 + p2] = t * 2 + 1;
  }
}

__device__ __forceinline__ bool moe_tile(const int* cnt, int tile, int rows_per_tile, int& e, int& r0, int& nrows) {
  int acc = 0;
  for (int i = 0; i < N_EXP; ++i) {
    int c = cnt[i];
    int nt = (c + rows_per_tile - 1) / rows_per_tile;
    if (tile < acc + nt) { e = i; r0 = (tile - acc) * rows_per_tile; nrows = min(rows_per_tile, c - r0); return true; }
    acc += nt;
  }
  return false;
}


__device__ __forceinline__ void moe_up_tile(const Params& p, int e, int r0, int nrows, int nb, char* smem) {
  const int tid = otid();
  int* arow = (int*)(smem + SMEM_EXTRA_OFF);
  int* aasg = arow + 128;
  __syncthreads();
  if (tid < 128) {
    int a = (tid < nrows) ? p.list[e * 65536 + r0 + tid] : -1;
    aasg[tid] = a;
    arow[tid] = (a >= 0) ? (a >> 1) : -1;
  }
  __syncthreads();
  gemm128(p.h, D_MODEL, arow, 0, p.wgu_t + (size_t)e * 1024 * 1024, D_MODEL, nb * 128, D_MODEL, smem, [&](int half, const float* sC) {
    int c4 = (tid & 15) * 4;
#pragma unroll
    for (int pass = 0; pass < 4; ++pass) {
      int r = pass * 16 + (tid >> 4);
      int a = aasg[half * 64 + r];
      if (a >= 0) {
        const float* src = sC + r * SC_LD + c4;
        float4 g = *(const float4*)src, uu = *(const float4*)(src + 64);
        uint2 o;
        o.x = pack2bf(silu_f(g.x) * uu.x, silu_f(g.y) * uu.y);
        o.y = pack2bf(silu_f(g.z) * uu.z, silu_f(g.w) * uu.w);
        *(uint2*)(p.hid + (size_t)a * D_EXP + nb * 64 + c4) = o;
      }
    }
  });
}
__global__ void __launch_bounds__(256) k_moe_up_mfma(Params p) {
  __shared__ __attribute__((aligned(16))) char smem[SMEM_TOTAL];
  for (int w = blockIdx.x;; w += gridDim.x) {
    int tile = w >> 3, nb = w & 7;
    int e, r0, nrows;
    if (!moe_tile(p.cnt, tile, 128, e, r0, nrows)) break;
    moe_up_tile(p, e, r0, nrows, nb, smem);
  }
}
__device__ __forceinline__ void moe_down_tile(const Params& p, int e, int r0, int nrows, int nb, char* smem) {
  const int tid = otid();
  int* arow = (int*)(smem + SMEM_EXTRA_OFF);
  __syncthreads();
  if (tid < 128) arow[tid] = (tid < nrows) ? p.list[e * 65536 + r0 + tid] : -1;
  __syncthreads();
  gemm128(p.hid, D_EXP, arow, 0, p.wd_t + (size_t)e * 1024 * 512, D_EXP, nb * 128, D_EXP, smem, [&](int half, const float* sC) {
    int c8 = (tid & 15) * 8;
#pragma unroll
    for (int pass = 0; pass < 4; ++pass) {
      int r = pass * 16 + (tid >> 4);
      int a = arow[half * 64 + r];
      if (a >= 0) {
        const float* src = sC + r * SC_LD + c8;
        float4 v0 = *(const float4*)src, v1 = *(const float4*)(src + 4);
        u32x4 o = {pack2bf(v0.x, v0.y), pack2bf(v0.z, v0.w), pack2bf(v1.x, v1.y), pack2bf(v1.z, v1.w)};
        *(u32x4*)(p.y + (size_t)a * D_MODEL + nb * 128 + c8) = o;
      }
    }
  });
}
__global__ void __launch_bounds__(256) k_moe_down_mfma(Params p) {
  __shared__ __attribute__((aligned(16))) char smem[SMEM_TOTAL];
  for (int w = blockIdx.x;; w += gridDim.x) {
    int tile = w >> 3, nb = w & 7;
    int e, r0, nrows;
    if (!moe_tile(p.cnt, tile, 128, e, r0, nrows)) break;
    moe_down_tile(p, e, r0, nrows, nb, smem);
  }
}

__global__ void __launch_bounds__(256) k_moe_up(Params p) {
  __shared__ GemmSmem s;
  __shared__ int rowtok[64];
  __shared__ int rowa[64];
  __shared__ float gacc[64][65];
  const int nt_n = D_EXP / 64;
  for (int w = blockIdx.x;; w += gridDim.x) {
    int tile = w / nt_n, nb = w % nt_n;
    int e, r0, nrows;
    if (!moe_tile(p.cnt, tile, 64, e, r0, nrows)) break;
    __syncthreads();
    if (threadIdx.x < 64) {
      int a = (threadIdx.x < nrows) ? p.list[e * 65536 + r0 + threadIdx.x] : -1;
      rowa[threadIdx.x] = a;
      rowtok[threadIdx.x] = (a >= 0) ? (a >> 1) : -1;
    }
    __syncthreads();
    int n0 = nb * 64;
    const float* Wg = p.w_gate + (size_t)e * D_MODEL * D_EXP;
    const float* Wu = p.w_up + (size_t)e * D_MODEL * D_EXP;
    gemm_tile_naive(p.h, D_MODEL, rowtok, Wg, D_EXP, D_MODEL, 0, n0, D_EXP, s,
                    [&](int r, int n, float v) { gacc[r][n - n0] = v; });
    bf16_t* hid = p.hid;
    gemm_tile_naive(p.h, D_MODEL, rowtok, Wu, D_EXP, D_MODEL, 0, n0, D_EXP, s,
                    [&](int r, int n, float v) {
                      int a = rowa[r];
                      if (a >= 0) hid[(size_t)a * D_EXP + n] = f2bf(silu_f(gacc[r][n - n0]) * v);
                    });
  }
}

__global__ void __launch_bounds__(256) k_moe_down(Params p) {
  __shared__ GemmSmem s;
  __shared__ int rowa[64];
  const int nt_n = D_MODEL / 64;
  for (int w = blockIdx.x;; w += gridDim.x) {
    int tile = w / nt_n, nb = w % nt_n;
    int e, r0, nrows;
    if (!moe_tile(p.cnt, tile, 64, e, r0, nrows)) break;
    __syncthreads();
    if (threadIdx.x < 64) rowa[threadIdx.x] = (threadIdx.x < nrows) ? p.list[e * 65536 + r0 + threadIdx.x] : -1;
    __syncthreads();
    int n0 = nb * 64;
    const float* Wd = p.w_down + (size_t)e * D_EXP * D_MODEL;
    bf16_t* y = p.y;
    gemm_tile_naive(p.hid, D_EXP, rowa, Wd, D_MODEL, D_EXP, 0, n0, D_MODEL, s,
                    [&](int r, int n, float v) {
                      int a = rowa[r];
                      if (a >= 0) y[(size_t)a * D_MODEL + n] = f2bf(v);
                    });
  }
}

__global__ void __launch_bounds__(256) k_final(Params p) {
  int t = blockIdx.x, b = t / SEQ, c0 = threadIdx.x * 4;
  float w0 = p.ewt[t * 2], w1 = p.ewt[t * 2 + 1];
  float4 xv = ((const float4*)(p.out + (size_t)t * D_MODEL))[threadIdx.x];
  ushort4 y0 = ((const ushort4*)(p.y + (size_t)(2 * t) * D_MODEL))[threadIdx.x];
  ushort4 y1 = ((const ushort4*)(p.y + (size_t)(2 * t + 1) * D_MODEL))[threadIdx.x];
  const float* g2 = p.mod + b * 6144 + 5120 + c0;
  xv.x += g2[0] * (w0 * bf2f(y0.x) + w1 * bf2f(y1.x));
  xv.y += g2[1] * (w0 * bf2f(y0.y) + w1 * bf2f(y1.y));
  xv.z += g2[2] * (w0 * bf2f(y0.z) + w1 * bf2f(y1.z));
  xv.w += g2[3] * (w0 * bf2f(y0.w) + w1 * bf2f(y1.w));
  ((float4*)(p.out + (size_t)t * D_MODEL))[threadIdx.x] = xv;
}


#define XB_TMO      128
#define XB_XCNT(j)  (256  + 64 * (j))
#define XB_XSUB(j)  (1280 + 64 * (j))
#define XB_XGEN(j)  (2304 + 64 * (j))
#define XB_TOP      3328
#define XB_TOPGEN   3392
#define XCD_BAR_WORDS 3456
#define XB_SPIN_CAP (1u << 20)
#define LAS __attribute__((address_space(3)))
__device__ __forceinline__ unsigned xb_ld(unsigned* p)              { return __hip_atomic_load(p, __ATOMIC_RELAXED, __HIP_MEMORY_SCOPE_AGENT); }
__device__ __forceinline__ unsigned xb_add(unsigned* p, unsigned v) { return __hip_atomic_fetch_add(p, v, __ATOMIC_RELAXED, __HIP_MEMORY_SCOPE_AGENT); }
__device__ __forceinline__ unsigned xb_xcc_id() { return (unsigned)__builtin_amdgcn_s_getreg((3 << 11) | 20) & 0xFu; }
#define XB_SPIN(cond, bar) do { unsigned _sp = 0; while (cond) { __builtin_amdgcn_s_sleep(1); \
    if ((++_sp & 255u) == 0u) { if (xb_ld(&(bar)[XB_TMO])) break; if (_sp > XB_SPIN_CAP) { atomicAdd(&(bar)[XB_TMO], 1u); break; } } } } while (0)
struct XcdBarrier { unsigned* bar; unsigned x; volatile LAS unsigned* st; };
__device__ __forceinline__ XcdBarrier xcd_barrier_post(unsigned* bar, volatile LAS unsigned* st) {
  XcdBarrier b; b.bar = bar; b.x = xb_xcc_id(); b.st = st;
  if (threadIdx.x == 0) (void)xb_add(&bar[XB_XCNT(b.x)], 1u);
  return b;
}
__device__ __forceinline__ void xcd_barrier_complete(unsigned* bar, unsigned x, unsigned& nloc, unsigned& nx) {
  const unsigned G = gridDim.x * gridDim.y * gridDim.z;
  unsigned sum, cnt, mine, sp = 0u;
  for (;;) {
    sum = 0u; cnt = 0u; mine = 0u;
#pragma unroll
    for (unsigned j = 0; j < 16; ++j) { const unsigned c = xb_ld(&bar[XB_XCNT(j)]); sum += c; cnt += (c > 0u) ? 1u : 0u; mine = (j == x) ? c : mine; }
    if (sum == G) break;
    __builtin_amdgcn_s_sleep(1);
    if ((++sp & 255u) == 0u) { if (xb_ld(&bar[XB_TMO])) break; if (sp > XB_SPIN_CAP) { atomicAdd(&bar[XB_TMO], 1u); break; } }
  }
  nloc = mine > 0u ? mine : 1u; nx = cnt > 0u ? cnt : 1u;
}
__device__ __forceinline__ void xcd_barrier(const XcdBarrier& b) {
  asm volatile("s_waitcnt vmcnt(0)" ::: "memory");
  __syncthreads();
  if (threadIdx.x == 0) {
    unsigned* bar = b.bar;
    __builtin_amdgcn_s_waitcnt(0);
    unsigned nloc = b.st[0], nx = b.st[1];
    if (nloc == 0u) { xcd_barrier_complete(bar, b.x, nloc, nx); b.st[0] = nloc; b.st[1] = nx; }
    const unsigned old = xb_add(&bar[XB_XSUB(b.x)], 1u);
    const unsigned gen = old / nloc;
    if (old + 1u == (gen + 1u) * nloc) {
      __builtin_amdgcn_fence(__ATOMIC_RELEASE, "agent");
      asm volatile("s_waitcnt vmcnt(0)" ::: "memory");
      const unsigned og = xb_add(&bar[XB_TOP], 1u);
      const unsigned tg = og / nx;
      if (og + 1u == (tg + 1u) * nx) xb_add(&bar[XB_TOPGEN], 1u);
      else XB_SPIN(xb_ld(&bar[XB_TOPGEN]) == tg, bar);
      __builtin_amdgcn_fence(__ATOMIC_ACQUIRE, "agent");
      xb_add(&bar[XB_XGEN(b.x)], 1u);
      asm volatile("s_waitcnt vmcnt(0)" ::: "memory");
    } else {
      XB_SPIN(xb_ld(&bar[XB_XGEN(b.x)]) == gen, bar);
      __builtin_amdgcn_fence(__ATOMIC_ACQUIRE, "agent");
      asm volatile("s_waitcnt vmcnt(0)" ::: "memory");
    }
  }
  __syncthreads();
}

__device__ __forceinline__ void mod_item(const Params& p, int item, char* smem) {
  const int tid = otid(), col = tid & 31, kg = tid >> 5, n0 = item * 32;
  float* ca = (float*)smem;
  __syncthreads();
  for (int e = tid; e < 16 * 1024; e += 256) {
    int b = e >> 10, k = e & 1023;
    ca[k * 16 + b] = silu_f(p.c[b * D_MODEL + k]);
  }
  __syncthreads();
  float acc[16];
#pragma unroll
  for (int b = 0; b < 16; ++b) acc[b] = 0.f;
  const float* wp = p.ada_w + (size_t)(kg * 128) * 6144 + n0 + col;
#pragma unroll 4
  for (int kk = 0; kk < 128; ++kk) {
    float wv = wp[(size_t)kk * 6144];
    const float4* cp = (const float4*)(ca + (kg * 128 + kk) * 16);
    float4 c0 = cp[0], c1 = cp[1], c2 = cp[2], c3 = cp[3];
    acc[0] += c0.x * wv; acc[1] += c0.y * wv; acc[2] += c0.z * wv; acc[3] += c0.w * wv;
    acc[4] += c1.x * wv; acc[5] += c1.y * wv; acc[6] += c1.z * wv; acc[7] += c1.w * wv;
    acc[8] += c2.x * wv; acc[9] += c2.y * wv; acc[10] += c2.z * wv; acc[11] += c2.w * wv;
    acc[12] += c3.x * wv; acc[13] += c3.y * wv; acc[14] += c3.z * wv; acc[15] += c3.w * wv;
  }
  __syncthreads();
  float* red = (float*)smem;
#pragma unroll
  for (int b = 0; b < 16; ++b) red[(kg * 16 + b) * 32 + col] = acc[b];
  __syncthreads();
  for (int o = tid; o < 512; o += 256) {
    int b = o >> 5, cc = o & 31;
    float s = p.ada_b[n0 + cc];
#pragma unroll
    for (int g = 0; g < 8; ++g) s += red[(g * 16 + b) * 32 + cc];
    p.mod[b * 6144 + n0 + cc] = s;
  }
}

__device__ __forceinline__ void misc_phase(const Params& p, int gtid, int gthreads) {
  for (int i = gtid; i < NTOK * 16; i += gthreads) {
    if (i < 2 * HG_W) {
      int d = i / HG_W, w = i % HG_W;
      float l0 = p.lb_logits[(d * 2 + 0) * HG_W + w], l1 = p.lb_logits[(d * 2 + 1) * HG_W + w];
      float m = fmaxf(l0, l1);
      float e0 = expf(l0 - m), e1 = expf(l1 - m);
      p.lb[i] = e0 / (e0 + e1);
    }
    int t = i >> 4, j = i & 15;
    float inv = powf(10000.0f, -(float)j / 16.0f);
    float ang = (float)p.pos[t] * inv;
    p.cs[t * 32 + j] = cosf(ang);
    p.cs[t * 32 + 16 + j] = sinf(ang);
    if (i < N_EXP) p.cnt[i] = 0;
    if (i < 4) p.qctr[i] = 0;
    if (i < 64) p.hcnt[i] = 0;
    if (i < 48 * 1024) {
      int row = i >> 10, kk = i & 1023;
      p.rwt[i] = row < 32 ? p.re_w[kk * 32 + row] : (row < 36 ? p.rg_w[kk * 4 + (row - 32)] : 0.f);
    }
  }
}

__device__ __forceinline__ void norm1_row(const Params& p, int t, float* red) {
  const int tid = otid(), b = t / SEQ;
  const float4 xv = ((const float4*)(p.x + (size_t)t * D_MODEL))[tid];
  float ss = xv.x * xv.x + xv.y * xv.y + xv.z * xv.z + xv.w * xv.w;
  ss = block_sum256(ss, red);
  float rstd = rsqrtf(ss * (1.f / D_MODEL) + EPS);
  int c0 = tid * 4;
  const float4 sh = *(const float4*)(p.mod + b * 6144 + c0), sc = *(const float4*)(p.mod + b * 6144 + 1024 + c0);
  const float4 g = *(const float4*)(p.norm1_g + c0);
  uint2 o;
  o.x = pack2bf(xv.x * rstd * g.x * (1.f + sc.x) + sh.x, xv.y * rstd * g.y * (1.f + sc.y) + sh.y);
  o.y = pack2bf(xv.z * rstd * g.z * (1.f + sc.z) + sh.z, xv.w * rstd * g.w * (1.f + sc.w) + sh.w);
  ((uint2*)(p.h + (size_t)t * D_MODEL))[tid] = o;
}

__device__ __forceinline__ void norm2_route_row(const Params& p, int t, float* red, float* lgs  ) {
  const int tid = threadIdx.x, b = t / SEQ;
  const float4 xv = ((const float4*)(p.out + (size_t)t * D_MODEL))[tid];
  float ss = xv.x * xv.x + xv.y * xv.y + xv.z * xv.z + xv.w * xv.w;
  ss = block_sum256(ss, red);
  float rstd = rsqrtf(ss * (1.f / D_MODEL) + EPS);
  int c0 = tid * 4;
  const float* shift = p.mod + b * 6144 + 3072, * scale = p.mod + b * 6144 + 4096;
  float v[4] = {xv.x, xv.y, xv.z, xv.w}, hv[4];
#pragma unroll
  for (int j = 0; j < 4; ++j) hv[j] = v[j] * rstd * p.norm2_g[c0 + j] * (1.f + scale[c0 + j]) + shift[c0 + j];
  uint2 o;
  o.x = pack2bf(hv[0], hv[1]); o.y = pack2bf(hv[2], hv[3]);
  ((uint2*)(p.h + (size_t)t * D_MODEL))[tid] = o;
  for (int e = 0; e < 36; ++e) {
    float a = 0.f;
#pragma unroll
    for (int j = 0; j < 4; ++j) {
      float wv = (e < 4) ? p.rg_w[(c0 + j) * 4 + e] : p.re_w[(c0 + j) * 32 + (e - 4)];
      a += hv[j] * wv;
    }
    a = wave_sum(a);
    if ((tid & 63) == 0) lgs[e * 4 + (tid >> 6)] = a;
  }
  __syncthreads();
  if (tid == 0) {
    float gl[4]; int gi = 0; float gm = -1e30f;
#pragma unroll
    for (int g = 0; g < 4; ++g) {
      gl[g] = lgs[g * 4 + 0] + lgs[g * 4 + 1] + lgs[g * 4 + 2] + lgs[g * 4 + 3] + p.rg_b[g];
      if (gl[g] > gm) { gm = gl[g]; gi = g; }
    }
    float gs = 0.f;
#pragma unroll
    for (int g = 0; g < 4; ++g) gs += expf(gl[g] - gm);
    float gp = 1.f / gs;
    float v1 = -1e30f, v2 = -1e30f; int i1 = 0, i2 = 0;
    for (int e = 0; e < 8; ++e) {
      int ee = 4 + gi * 8 + e;
      float l = lgs[ee * 4 + 0] + lgs[ee * 4 + 1] + lgs[ee * 4 + 2] + lgs[ee * 4 + 3] + p.re_b[gi * 8 + e];
      if (l > v1) { v2 = v1; i2 = i1; v1 = l; i1 = e; }
      else if (l > v2) { v2 = l; i2 = e; }
    }
    float e2 = expf(v2 - v1);
    float w1 = gp / (1.f + e2), w2 = gp * e2 / (1.f + e2);
    int ex1 = gi * 8 + i1, ex2 = gi * 8 + i2;
    p.ewt[t * 2] = w1; p.ewt[t * 2 + 1] = w2;
    int p1 = atomicAdd(&p.cnt[ex1], 1); p.list[ex1 * 65536 + p1] = t * 2;
    int p2 = atomicAdd(&p.cnt[ex2], 1); p.list[ex2 * 65536 + p2] = t * 2 + 1;
  }
}


#define RT_LD 1028
__device__ __forceinline__ void route_group(const Params& p, int grp, char* smem) {
  const int tid = otid(), lane = tid & 63, w = tid >> 6;
  float* h2s = (float*)smem;
  float* part = (float*)(smem + 8 * RT_LD * 4);
  const int t0 = grp * 8, b = t0 / SEQ;
  __syncthreads();
#pragma unroll
  for (int tt = 0; tt < 2; ++tt) {
    const int tl = w * 2 + tt, t = t0 + tl;
    float4 xv[4];
    float ss = 0.f;
#pragma unroll
    for (int i = 0; i < 4; ++i) {
      xv[i] = *(const float4*)(p.out + (size_t)t * D_MODEL + lane * 4 + 256 * i);
      ss += xv[i].x * xv[i].x + xv[i].y * xv[i].y + xv[i].z * xv[i].z + xv[i].w * xv[i].w;
    }
    ss = wave_sum(ss);
    const float rstd = rsqrtf(ss * (1.f / D_MODEL) + EPS);
#pragma unroll
    for (int i = 0; i < 4; ++i) {
      const int c0 = lane * 4 + 256 * i;
      const float4 g = *(const float4*)(p.norm2_g + c0);
      const float4 sh = *(const float4*)(p.mod + b * 6144 + 3072 + c0);
      const float4 sc = *(const float4*)(p.mod + b * 6144 + 4096 + c0);
      float4 hv;
      hv.x = xv[i].x * rstd * g.x * (1.f + sc.x) + sh.x;
      hv.y = xv[i].y * rstd * g.y * (1.f + sc.y) + sh.y;
      hv.z = xv[i].z * rstd * g.z * (1.f + sc.z) + sh.z;
      hv.w = xv[i].w * rstd * g.w * (1.f + sc.w) + sh.w;
      uint2 o; o.x = pack2bf(hv.x, hv.y); o.y = pack2bf(hv.z, hv.w);
      *(uint2*)(p.h + (size_t)t * D_MODEL + c0) = o;
      *(float4*)(h2s + tl * RT_LD + c0) = hv;
    }
  }
  __syncthreads();
  {
    const int j16 = lane & 15, q = lane >> 4;
    f32x4 acc0 = {0.f, 0.f, 0.f, 0.f}, acc1 = acc0, acc2 = acc0;
    const float* ap = h2s + (lane & 7) * RT_LD + w * 256 + 4 * q;
    const float* bp = p.rwt + (size_t)j16 * 1024 + w * 256 + 4 * q;
#pragma unroll 4
    for (int kb = 0; kb < 16; ++kb) {
      const float4 a4 = *(const float4*)(ap + kb * 16);
      const float4 b0 = *(const float4*)(bp + kb * 16);
      const float4 b1 = *(const float4*)(bp + 16 * 1024 + kb * 16);
      const float4 b2 = *(const float4*)(bp + 32 * 1024 + kb * 16);
      acc0 = __builtin_amdgcn_mfma_f32_16x16x4f32(a4.x, b0.x, acc0, 0, 0, 0);
      acc1 = __builtin_amdgcn_mfma_f32_16x16x4f32(a4.x, b1.x, acc1, 0, 0, 0);
      acc2 = __builtin_amdgcn_mfma_f32_16x16x4f32(a4.x, b2.x, acc2, 0, 0, 0);
      acc0 = __builtin_amdgcn_mfma_f32_16x16x4f32(a4.y, b0.y, acc0, 0, 0, 0);
      acc1 = __builtin_amdgcn_mfma_f32_16x16x4f32(a4.y, b1.y, acc1, 0, 0, 0);
      acc2 = __builtin_amdgcn_mfma_f32_16x16x4f32(a4.y, b2.y, acc2, 0, 0, 0);
      acc0 = __builtin_amdgcn_mfma_f32_16x16x4f32(a4.z, b0.z, acc0, 0, 0, 0);
      acc1 = __builtin_amdgcn_mfma_f32_16x16x4f32(a4.z, b1.z, acc1, 0, 0, 0);
      acc2 = __builtin_amdgcn_mfma_f32_16x16x4f32(a4.z, b2.z, acc2, 0, 0, 0);
      acc0 = __builtin_amdgcn_mfma_f32_16x16x4f32(a4.w, b0.w, acc0, 0, 0, 0);
      acc1 = __builtin_amdgcn_mfma_f32_16x16x4f32(a4.w, b1.w, acc1, 0, 0, 0);
      acc2 = __builtin_amdgcn_mfma_f32_16x16x4f32(a4.w, b2.w, acc2, 0, 0, 0);
    }
    if (q < 2) {
#pragma unroll
      for (int r = 0; r < 4; ++r) {
        float* pr = part + (w * 8 + 4 * q + r) * 48 + j16;
        pr[0] = acc0[r]; pr[16] = acc1[r]; pr[32] = acc2[r];
      }
    }
  }
  __syncthreads();
  if (tid < 8) {
    const int t = t0 + tid;
    float gl0 = p.rg_b[0], gl1 = p.rg_b[1], gl2 = p.rg_b[2], gl3 = p.rg_b[3];
#pragma unroll
    for (int ws = 0; ws < 4; ++ws) {
      const float* pp = part + (ws * 8 + tid) * 48 + 32;
      gl0 += pp[0]; gl1 += pp[1]; gl2 += pp[2]; gl3 += pp[3];
    }
    float gm = gl0; int gi = 0;
    if (gl1 > gm) { gm = gl1; gi = 1; }
    if (gl2 > gm) { gm = gl2; gi = 2; }
    if (gl3 > gm) { gm = gl3; gi = 3; }
    const float gs = expf(gl0 - gm) + expf(gl1 - gm) + expf(gl2 - gm) + expf(gl3 - gm);
    const float gp = 1.f / gs;
    float v1 = -1e30f, v2 = -1e30f; int i1 = 0, i2 = 0;
    for (int e8 = 0; e8 < 8; ++e8) {
      const int e = gi * 8 + e8;
      float l = p.re_b[e];
#pragma unroll
      for (int ws = 0; ws < 4; ++ws) l += part[(ws * 8 + tid) * 48 + e];
      if (l > v1) { v2 = v1; i2 = i1; v1 = l; i1 = e; }
      else if (l > v2) { v2 = l; i2 = e; }
    }
    const float e2 = expf(v2 - v1);
    const float w1 = gp / (1.f + e2), w2 = gp * e2 / (1.f + e2);
    p.ewt[t * 2] = w1; p.ewt[t * 2 + 1] = w2;
    int p1 = atomicAdd(&p.cnt[i1], 1); p.list[i1 * 65536 + p1] = t * 2;
    int p2 = atomicAdd(&p.cnt[i2], 1); p.list[i2 * 65536 + p2] = t * 2 + 1;
  }
}

__device__ __forceinline__ void final_row(const Params& p, int t) {
  const int tid = otid(), b = t / SEQ, c0 = tid * 4;
  float w0 = p.ewt[t * 2], w1 = p.ewt[t * 2 + 1];
  float4 xv = ((const float4*)(p.out + (size_t)t * D_MODEL))[tid];
  uint2 y0 = ((const uint2*)(p.y + (size_t)(2 * t) * D_MODEL))[tid];
  uint2 y1 = ((const uint2*)(p.y + (size_t)(2 * t + 1) * D_MODEL))[tid];
  const float4 g2 = *(const float4*)(p.mod + b * 6144 + 5120 + c0);
  xv.x += g2.x * (w0 * __uint_as_float(y0.x << 16) + w1 * __uint_as_float(y1.x << 16));
  xv.y += g2.y * (w0 * __uint_as_float(y0.x & 0xffff0000u) + w1 * __uint_as_float(y1.x & 0xffff0000u));
  xv.z += g2.z * (w0 * __uint_as_float(y0.y << 16) + w1 * __uint_as_float(y1.y << 16));
  xv.w += g2.w * (w0 * __uint_as_float(y0.y & 0xffff0000u) + w1 * __uint_as_float(y1.y & 0xffff0000u));
  ((float4*)(p.out + (size_t)t * D_MODEL))[tid] = xv;
}

#ifndef XREP_P0
#define XREP_P0 0
#endif
#ifndef XREP_P1
#define XREP_P1 0
#endif
#ifndef XREP_P2
#define XREP_P2 0
#endif
#ifndef XREP_P3
#define XREP_P3 0
#endif
#ifndef XREP_ATT
#define XREP_ATT 0
#endif
#ifndef XREP_HG
#define XREP_HG 0
#endif
#ifndef XREP_P5
#define XREP_P5 0
#endif
#ifndef XREP_MOE
#define XREP_MOE 0
#endif
#define N_HG_ITEMS (BATCH * HG_HEADS * 2)
#define N_ATT_ITEMS (BATCH * MLA_HEADS * 16)

__global__ void __launch_bounds__(256, 2) k_mega(Params p) {
  cg::grid_group grid = cg::this_grid();
  __shared__ __attribute__((aligned(16))) char smem[HG_SMEM + 64];
  const int nb = gridDim.x, bid = blockIdx.x, tid = threadIdx.x;
  volatile LAS unsigned* xst = (volatile LAS unsigned*)(smem + HG_SMEM + 32);
  if (tid == 0) { xst[0] = 0u; xst[1] = 0u; }
  __syncthreads();
  const XcdBarrier xb = xcd_barrier_post(p.bar, xst);
  float* red = (float*)(smem + 65536);
  misc_phase(p, bid * 256 + tid, nb * 256);
  for (int it = bid; it < 6144 / 32; it += nb) mod_item(p, it, smem);
  __syncthreads();
  for (int job = nb - 1 - bid; job < CVT_TOTAL; job += nb) cvt_job(p, job, (float*)smem);
  grid.sync();
  for (int rep = 0; rep < XREP_P0; ++rep) {
    for (int it = bid; it < 6144 / 32; it += nb) mod_item(p, it, smem);
    __syncthreads();
    for (int job = nb - 1 - bid; job < CVT_TOTAL; job += nb) cvt_job(p, job, (float*)smem);
    xcd_barrier(xb);
  }
  for (int rep = 0; rep <= XREP_P1; ++rep) {
    for (int t = bid; t < NTOK; t += nb) norm1_row(p, t, red);
    xcd_barrier(xb);
  }
  for (int rep = 0; rep <= XREP_P2; ++rep) {
    for (int t = bid; t < (NTOK / 128) * 26; t += nb) proj_tile(p, t, smem);
    xcd_barrier(xb);
  }
  for (int rep = 0; rep <= XREP_P3; ++rep) {
    for (int t = bid; t < (NTOK / 128) * 16; t += nb) mla_up_tile(p, t, smem);
    xcd_barrier(xb);
  }
  {
    int* qi = (int*)(smem + HG_SMEM);
    for (;;) {
      __syncthreads();
      if (tid == 0) *qi = atomicAdd(&p.qctr[0], 1);
      __syncthreads();
      int it = *qi;
      if (it >= N_HG_ITEMS + N_ATT_ITEMS) break;
      if (it < N_HG_ITEMS) hgrn_item(p, it, smem);
      else attn_item(p, it - N_HG_ITEMS, smem);
    }
    for (int rep = 0; rep < XREP_ATT; ++rep) {
      xcd_barrier(xb);
      for (;;) {
        __syncthreads();
        if (tid == 0) *qi = atomicAdd(&p.qctr[1], 1);
        __syncthreads();
        int it = *qi;
        if (it >= N_ATT_ITEMS) break;
        attn_item(p, it, smem);
      }
    }
    for (int rep = 0; rep < XREP_HG; ++rep) {
      xcd_barrier(xb);
      for (;;) {
        __syncthreads();
        if (tid == 0) *qi = atomicAdd(&p.qctr[2], 1);
        __syncthreads();
        int it = *qi;
        if (it >= N_HG_ITEMS) break;
        hgrn_item(p, it, smem);
      }
    }
  }
  xcd_barrier(xb);
  for (int rep = 0; rep <= XREP_P5; ++rep) {
    for (int t = bid; t < (NTOK / 128) * 8; t += nb) outproj_tile(p, t, smem);
    xcd_barrier(xb);
  }
  for (int g = bid; g < NTOK / 8; g += nb) route_group(p, g, smem);
  xcd_barrier(xb);
  for (int rep = 0; rep <= XREP_MOE; ++rep) {
  for (int w = bid;; w += nb) {
    int tile = w >> 3, nbk = w & 7, e, r0, nrows;
    if (!moe_tile(p.cnt, tile, 128, e, r0, nrows)) break;
    moe_up_tile(p, e, r0, nrows, nbk, smem);
  }
  xcd_barrier(xb);
  for (int w = bid;; w += nb) {
    int tile = w >> 3, nbk = w & 7, e, r0, nrows;
    if (!moe_tile(p.cnt, tile, 128, e, r0, nrows)) break;
    moe_down_tile(p, e, r0, nrows, nbk, smem);
  }
  xcd_barrier(xb);
  }
  for (int t = bid; t < NTOK; t += nb) final_row(p, t);
}

static inline size_t align_up(size_t v, size_t a) { return (v + a - 1) / a * a; }

extern "C" void kernel_launch(void* const* d_in, const int* in_sizes, int n_in, void* d_out, int out_size, void* d_ws,
                              size_t ws_size, hipStream_t stream) {
  Params p{};
  p.x = (const float*)d_in[0]; p.c = (const float*)d_in[1]; p.pos = (const int*)d_in[2];
  p.ada_w = (const float*)d_in[3]; p.ada_b = (const float*)d_in[4]; p.norm1_g = (const float*)d_in[5];
  p.w_in = (const float*)d_in[6]; p.qa_g = (const float*)d_in[7]; p.wq_up = (const float*)d_in[8];
  p.kva_g = (const float*)d_in[9]; p.wkv_up = (const float*)d_in[10]; p.qn_g = (const float*)d_in[11];
  p.kn_g = (const float*)d_in[12]; p.lb_logits = (const float*)d_in[13]; p.hg_norm_g = (const float*)d_in[14];
  p.w_out = (const float*)d_in[15]; p.norm2_g = (const float*)d_in[16]; p.rg_w = (const float*)d_in[17];
  p.rg_b = (const float*)d_in[18]; p.re_w = (const float*)d_in[19]; p.re_b = (const float*)d_in[20];
  p.w_gate = (const float*)d_in[21]; p.w_up = (const float*)d_in[22]; p.w_down = (const float*)d_in[23];
  p.out = (float*)d_out;
  char* ws = (char*)d_ws;
  size_t off = 0;
  auto take = [&](size_t bytes) { size_t o = off; off = align_up(off + bytes, 256); return ws + o; };
  p.mod = (float*)take(16 * 6144 * 4);
  p.lb = (float*)take(2 * HG_W * 4);
  p.cs = (float*)take((size_t)NTOK * 32 * 4);
  p.eid = (int*)take((size_t)NTOK * 2 * 4);
  p.ewt = (float*)take((size_t)NTOK * 2 * 4);
  p.cnt = (int*)take(N_EXP * 4);
  p.qctr = (int*)take(16);
  p.hcnt = (int*)take(64 * 4);
  p.bar = (unsigned*)take(XCD_BAR_WORDS * 4);
  p.rwt = (float*)take(48 * 1024 * 4);
  p.list = (int*)take((size_t)N_EXP * 65536 * 4);
  p.h = (bf16_t*)take((size_t)NTOK * D_MODEL * 2);
  p.proj = (bf16_t*)take((size_t)NTOK * IN_COLS * 2);
  p.mix = (bf16_t*)take((size_t)NTOK * D_MODEL * 2);
  p.wgu_t = (bf16_t*)take((size_t)N_EXP * 1024 * 1024 * 2);
  p.wd_t = (bf16_t*)take((size_t)N_EXP * 1024 * 512 * 2);
  p.w_in_t = (bf16_t*)take((size_t)3328 * 1024 * 2);
  p.wq_t = (bf16_t*)take((size_t)800 * 384 * 2);
  p.wkv_t = (bf16_t*)take((size_t)1024 * 256 * 2);
  p.w_out_t = (bf16_t*)take((size_t)1024 * 1024 * 2);
  p.hiT = (bf16_t*)take((size_t)NTOK * HG_W * 2);
  p.of16 = p.h;
  p.o_f = (float*)p.h;
  p.o_b = (float*)p.wgu_t;
  p.qkv_raw = p.mix;
  p.hid = p.proj;
  p.y = p.proj + (size_t)NASSIGN * D_EXP;
  p.Q = (bf16_t*)d_out;
  p.Kk = p.Q + (size_t)NTOK * MLA_HEADS * QK_DIM;
  p.V = p.Kk + (size_t)NTOK * MLA_HEADS * QK_DIM;
  (void)ws_size; (void)in_sizes; (void)n_in; (void)out_size;

  static int grid_blocks = 0;
  if (!grid_blocks) {
    int dev = 0, cus = 0, per_cu = 0;
    (void)hipGetDevice(&dev);
    (void)hipDeviceGetAttribute(&cus, hipDeviceAttributeMultiprocessorCount, dev);
    (void)hipOccupancyMaxActiveBlocksPerMultiprocessor(&per_cu, k_mega, 256, 0);
    if (per_cu > 2) per_cu = 2;
    grid_blocks = cus * per_cu;
  }
  (void)hipMemsetAsync(p.bar, 0, XCD_BAR_WORDS * 4, stream);
  void* args[] = {&p};
  hipError_t e = hipLaunchCooperativeKernel((void*)k_mega, dim3(grid_blocks), dim3(256), args, 0, stream);
  if (e != hipSuccess) fprintf(stderr, "cooperative launch failed: %s (grid %d)\n", hipGetErrorString(e), grid_blocks);
}
```

```cpp
#include <hip/hip_runtime.h>
#include <hip/hip_cooperative_groups.h>
#include <stdint.h>
#include <stdio.h>
namespace cg = cooperative_groups;

#define D_MODEL 1024
#define BATCH 16
#define SEQ 2048
#define NTOK (BATCH * SEQ)
#define MLA_HEADS 8
#define QK_DIM 96
#define V_DIM 64
#define NOPE 64
#define ROPE 32
#define Q_LORA 384
#define KV_LORA 256
#define HG_HEADS 4
#define HG_DIM 128
#define HG_W 512
#define IN_COLS 3232
#define N_EXP 32
#define CNT_STRIDE 64
#define D_EXP 512
#define NASSIGN (NTOK * 2)
#define EPS 1e-6f
#define C_HQ 0
#define C_HFF 512
#define C_HFB 1024
#define C_HI 1536
#define C_HG 2048
#define C_QLAT 2560
#define C_KVLAT 2944
#define C_KROPE 3200

typedef unsigned short bf16_t;

__device__ __forceinline__ float bf2f(bf16_t v) { return __uint_as_float(((unsigned)v) << 16); }
__device__ __forceinline__ bf16_t f2bf(float f) {
  unsigned u = __float_as_uint(f);
  u += 0x7fffu + ((u >> 16) & 1u);
  return (bf16_t)(u >> 16);
}
typedef __bf16 bf16n2 __attribute__((ext_vector_type(2)));
typedef float f32x2 __attribute__((ext_vector_type(2)));
__device__ __forceinline__ unsigned pack2bf(float a, float b) {
  f32x2 v = {a, b};
  return __builtin_bit_cast(unsigned, __builtin_convertvector(v, bf16n2));
}
__device__ __forceinline__ int otid() { int t = threadIdx.x; asm volatile("" : "+v"(t)); return t; }
__device__ __forceinline__ float silu_f(float x) { return x / (1.f + __expf(-x)); }
__device__ __forceinline__ float sigmoid_f(float x) { return 1.f / (1.f + __expf(-x)); }

__device__ __forceinline__ float wave_sum(float v) {
#pragma unroll
  for (int o = 32; o > 0; o >>= 1) v += __shfl_xor(v, o);
  return v;
}
__device__ __forceinline__ float wave_max(float v) {
#pragma unroll
  for (int o = 32; o > 0; o >>= 1) v = fmaxf(v, __shfl_xor(v, o));
  return v;
}
__device__ __forceinline__ float block_sum256(float v, float* red) {
  v = wave_sum(v);
  __syncthreads();
  if ((threadIdx.x & 63) == 0) red[threadIdx.x >> 6] = v;
  __syncthreads();
  return red[0] + red[1] + red[2] + red[3];
}

struct Params {
  const float* x; const float* c; const int* pos;
  const float* ada_w; const float* ada_b; const float* norm1_g; const float* w_in;
  const float* qa_g; const float* wq_up; const float* kva_g; const float* wkv_up;
  const float* qn_g; const float* kn_g; const float* lb_logits; const float* hg_norm_g;
  const float* w_out; const float* norm2_g; const float* rg_w; const float* rg_b;
  const float* re_w; const float* re_b; const float* w_gate; const float* w_up; const float* w_down;
  float* out;
  float* mod;
  float* lb;
  float* cs;
  bf16_t* h;
  bf16_t* proj;
  bf16_t* mix;
  bf16_t* Q;
  bf16_t* Kk;
  bf16_t* V;
  float* ewt;
  int* cnt;
  int* qctr;
  int* hcnt;
  float* rwt;
  unsigned* bar;
  int* list;
  bf16_t* hid;
  bf16_t* y;
  bf16_t* of16;
  bf16_t* hiT;
  bf16_t* w_in_t;
  bf16_t* wq_t;
  bf16_t* wkv_t;
  bf16_t* w_out_t;
  bf16_t* wgu_t;
  bf16_t* wd_t;
};

__device__ __forceinline__ int win_perm(int n) {
  if (n < 384) return C_QLAT + n;
  if (n < 640) return C_KVLAT + (n - 384);
  if (n < 672) return C_KROPE + (n - 640);
  if (n < 3232) return n - 672;
  return n;
}
template <bool WIN_PERM = false>
__device__ __forceinline__ void cvt_tile(const float* __restrict__ src, int ld_src, int K, int N, int k0, int n0,
                                         bf16_t* __restrict__ dst, int ld_dst, int dst_row0, const float* kscale, float* tile) {
  const int tid = otid();
  for (int e = tid; e < 4096; e += 256) {
    int kk = e >> 6, nn = e & 63;
    float v = 0.f;
    if (n0 + nn < N && k0 + kk < K) v = src[(size_t)(k0 + kk) * ld_src + n0 + nn];
    if (kscale) v *= kscale[k0 + kk];
    tile[kk * 65 + nn] = v;
  }
  __syncthreads();
  for (int e = tid; e < 4096; e += 256) {
    int nn = e >> 6, kk = e & 63;
    int drow = WIN_PERM ? win_perm(n0 + nn) : dst_row0 + nn;
    dst[(size_t)drow * ld_dst + k0 + kk] = f2bf(tile[kk * 65 + nn]);
  }
  __syncthreads();
}

#define CVT_WIN_TILES (16 * 52)
#define CVT_WQ_TILES (6 * 12)
#define CVT_WKV_TILES (4 * 16)
#define CVT_WOUT_TILES (16 * 16)
#define CVT_EXP_TILES (N_EXP * 384)
#define CVT_TOTAL (CVT_WIN_TILES + CVT_WQ_TILES + CVT_WKV_TILES + CVT_WOUT_TILES + CVT_EXP_TILES)

__device__ __forceinline__ void cvt_job(const Params& p, int job, float* tile) {
  if (job < CVT_WIN_TILES) {
    int kt = job / 52, nt = job % 52;
    cvt_tile<true>(p.w_in, IN_COLS, D_MODEL, IN_COLS, kt * 64, nt * 64, p.w_in_t, D_MODEL, nt * 64, nullptr, tile);
    return;
  }
  job -= CVT_WIN_TILES;
  if (job < CVT_WQ_TILES) {
    int kt = job / 12, nt = job % 12;
    cvt_tile(p.wq_up, 768, Q_LORA, 768, kt * 64, nt * 64, p.wq_t, Q_LORA, nt * 64, p.qa_g, tile);
    return;
  }
  job -= CVT_WQ_TILES;
  if (job < CVT_WKV_TILES) {
    int kt = job / 16, nt = job % 16;
    cvt_tile(p.wkv_up, 1024, KV_LORA, 1024, kt * 64, nt * 64, p.wkv_t, KV_LORA, nt * 64, p.kva_g, tile);
    return;
  }
  job -= CVT_WKV_TILES;
  if (job < CVT_WOUT_TILES) {
    int kt = job / 16, nt = job % 16;
    cvt_tile(p.w_out, D_MODEL, D_MODEL, D_MODEL, kt * 64, nt * 64, p.w_out_t, D_MODEL, nt * 64, nullptr, tile);
    return;
  }
  job -= CVT_WOUT_TILES;
  {
    int e = job / 384, r = job % 384;
    if (r < 128) {
      int kt = r / 8, nt = r % 8;
      cvt_tile(p.w_gate + (size_t)e * D_MODEL * D_EXP, D_EXP, D_MODEL, D_EXP, kt * 64, nt * 64,
               p.wgu_t + (size_t)e * 1024 * 1024, D_MODEL, nt * 128, nullptr, tile);
    } else if (r < 256) {
      r -= 128;
      int kt = r / 8, nt = r % 8;
      cvt_tile(p.w_up + (size_t)e * D_MODEL * D_EXP, D_EXP, D_MODEL, D_EXP, kt * 64, nt * 64,
               p.wgu_t + (size_t)e * 1024 * 1024, D_MODEL, nt * 128 + 64, nullptr, tile);
    } else {
      r -= 256;
      int kt = r / 16, nt = r % 16;
      cvt_tile(p.w_down + (size_t)e * D_EXP * D_MODEL, D_MODEL, D_EXP, D_MODEL, kt * 64, nt * 64,
               p.wd_t + (size_t)e * 1024 * 512, D_EXP, nt * 64, nullptr, tile);
    }
  }
}

#define CVT_SMALL (CVT_TOTAL - CVT_EXP_TILES)
using bf16x8 = __attribute__((ext_vector_type(8))) short;
using f32x4 = __attribute__((ext_vector_type(4))) float;
using u32x4 = __attribute__((ext_vector_type(4))) unsigned;
#define SC_LD 132
#define GEMM_SMEM_BYTES (64 * SC_LD * 4)

template <class Epi>
__device__ __forceinline__ void gemm128(const bf16_t* __restrict__ A, long lda, const int* arow, int m0,
                                        const bf16_t* __restrict__ Bt, long ldb, int n0, int K, char* smem, Epi epi) {
  const int tid = otid(), lane = tid & 63, wid = tid >> 6, wm = wid >> 1, wn = wid & 1;
  char* sA = smem;
  char* sB = smem + 16384;
  float* sC = (float*)smem;
  f32x4 acc[4][4];
#pragma unroll
  for (int i = 0; i < 4; ++i)
#pragma unroll
    for (int j = 0; j < 4; ++j) acc[i][j] = (f32x4){0.f, 0.f, 0.f, 0.f};
  const bf16_t* ap[4];
  const bf16_t* bp[4];
  int soff[4];
#pragma unroll
  for (int i = 0; i < 4; ++i) {
    int c = tid + 256 * i, row = c >> 3, ch = c & 7;
    long ar = arow ? (long)arow[row] : (long)(m0 + row);
    if (ar < 0) ar = 0;
    ap[i] = A + ar * lda + ch * 8;
    bp[i] = Bt + (long)(n0 + row) * ldb + ch * 8;
    soff[i] = row * 128 + ((ch ^ (row & 7)) << 4);
  }
  u32x4 ra[4], rb[4];
#pragma unroll
  for (int i = 0; i < 4; ++i) {
    ra[i] = *(const u32x4*)(ap[i]);
    rb[i] = *(const u32x4*)(bp[i]);
  }
  const int frow = lane & 15, fq = lane >> 4;
  auto stage_store = [&]() {
#pragma unroll
    for (int i = 0; i < 4; ++i) {
      *(u32x4*)(sA + soff[i]) = ra[i];
      *(u32x4*)(sB + soff[i]) = rb[i];
    }
  };
  auto compute = [&]() {
#pragma unroll
    for (int ks = 0; ks < 2; ++ks) {
      bf16x8 af[4], bfr[4];
#pragma unroll
      for (int i = 0; i < 4; ++i) {
        int row = wm * 64 + i * 16 + frow;
        af[i] = *(const bf16x8*)(sA + row * 128 + (((ks * 4 + fq) ^ (row & 7)) << 4));
      }
#pragma unroll
      for (int j = 0; j < 4; ++j) {
        int row = wn * 64 + j * 16 + frow;
        bfr[j] = *(const bf16x8*)(sB + row * 128 + (((ks * 4 + fq) ^ (row & 7)) << 4));
      }
#pragma unroll
      for (int i = 0; i < 4; ++i)
#pragma unroll
        for (int j = 0; j < 4; ++j) acc[i][j] = __builtin_amdgcn_mfma_f32_16x16x32_bf16(af[i], bfr[j], acc[i][j], 0, 0, 0);
    }
  };
  for (int k0 = 64; k0 < K; k0 += 64) {
    __syncthreads();
    stage_store();
    __syncthreads();
#pragma unroll
    for (int i = 0; i < 4; ++i) {
      ra[i] = *(const u32x4*)(ap[i] + k0);
      rb[i] = *(const u32x4*)(bp[i] + k0);
    }
    compute();
  }
  __syncthreads();
  stage_store();
  __syncthreads();
  compute();
#pragma unroll
  for (int half = 0; half < 2; ++half) {
    __syncthreads();
    if (wm == half) {
#pragma unroll
      for (int i = 0; i < 4; ++i)
#pragma unroll
        for (int j = 0; j < 4; ++j)
#pragma unroll
          for (int r = 0; r < 4; ++r) sC[(i * 16 + fq * 4 + r) * SC_LD + wn * 64 + j * 16 + frow] = acc[i][j][r];
    }
    __syncthreads();
    epi(half, sC);
  }
}

__device__ __forceinline__ void proj_tile(const Params& p, int t, char* smem) {
  const int NT = 26;
  int mt = t / NT, nt = t % NT;
  int m0 = mt * 128, n0 = nt * 128;
  bf16_t* C = p.proj;
  gemm128(p.h, D_MODEL, nullptr, m0, p.w_in_t, D_MODEL, n0, D_MODEL, smem, [&](int half, const float* sC) {
    const int tid = otid();
    if (nt >= 12 && nt < 16) {
      int vv = tid & 127, g = tid >> 7;
      int b = m0 / SEQ, hh = nt - 12;
      int sidx0 = m0 - b * SEQ + half * 64 + g * 32;
      bf16_t* dst = p.hiT + ((size_t)(b * HG_HEADS + hh) * HG_DIM + vv) * SEQ + sidx0;
#pragma unroll
      for (int q = 0; q < 4; ++q) {
        float t8[8];
#pragma unroll
        for (int e = 0; e < 8; ++e) t8[e] = sC[(g * 32 + q * 8 + e) * SC_LD + vv];
        u32x4 o = {pack2bf(t8[0], t8[1]), pack2bf(t8[2], t8[3]), pack2bf(t8[4], t8[5]), pack2bf(t8[6], t8[7])};
        *(u32x4*)(dst + q * 8) = o;
      }
    } else {
      int c8 = (tid & 15) * 8;
      if (n0 + c8 < IN_COLS) {
#pragma unroll
        for (int pass = 0; pass < 4; ++pass) {
          int r = pass * 16 + (tid >> 4);
          const float* src = sC + r * SC_LD + c8;
          float4 v0 = *(const float4*)src, v1 = *(const float4*)(src + 4);
          u32x4 o = {pack2bf(v0.x, v0.y), pack2bf(v0.z, v0.w), pack2bf(v1.x, v1.y), pack2bf(v1.z, v1.w)};
          *(u32x4*)(C + (size_t)(m0 + half * 64 + r) * IN_COLS + n0 + c8) = o;
        }
      }
    }
  });
}
#define SMEM_EXTRA_OFF GEMM_SMEM_BYTES
#define SMEM_TOTAL (GEMM_SMEM_BYTES + 1024)

__device__ __forceinline__ void outproj_tile(const Params& p, int t, char* smem) {
  int mt = t >> 3, nt = t & 7;
  int m0 = mt * 128, n0 = nt * 128;
  gemm128(p.mix, D_MODEL, nullptr, m0, p.w_out_t, D_MODEL, n0, D_MODEL, smem, [&](int half, const float* sC) {
    const int tid = otid();
    int c8 = (tid & 15) * 8;
    int b = m0 / SEQ;
    const float* gate = p.mod + b * 6144 + 2048 + n0 + c8;
    float4 g0 = *(const float4*)gate, g1 = *(const float4*)(gate + 4);
#pragma unroll
    for (int pass = 0; pass < 4; ++pass) {
      int r = pass * 16 + (tid >> 4);
      const float* src = sC + r * SC_LD + c8;
      float4 v0 = *(const float4*)src, v1 = *(const float4*)(src + 4);
      size_t go = (size_t)(m0 + half * 64 + r) * D_MODEL + n0 + c8;
      float4 x0 = *(const float4*)(p.x + go), x1 = *(const float4*)(p.x + go + 4);
      x0.x += g0.x * v0.x; x0.y += g0.y * v0.y; x0.z += g0.z * v0.z; x0.w += g0.w * v0.w;
      x1.x += g1.x * v1.x; x1.y += g1.y * v1.y; x1.z += g1.z * v1.z; x1.w += g1.w * v1.w;
      *(float4*)(p.out + go) = x0;
      *(float4*)(p.out + go + 4) = x1;
    }
  });
}
__device__ __forceinline__ void mla_up_tile(const Params& p, int t, char* smem) {
  const int tid = otid();
  int mt = t >> 4, u = t & 15;
  int m0 = mt * 128;
  float* rs = (float*)(smem + SMEM_EXTRA_OFF);
  const bool isq = u < 8;
  {
    int r = tid >> 1, part = tid & 1;
    const bf16_t* row = p.proj + (size_t)(m0 + r) * IN_COLS + (isq ? C_QLAT : C_KVLAT);
    int n = isq ? Q_LORA / 2 : KV_LORA / 2;
    const u32x4* src = (const u32x4*)(row + part * n);
    float ss = 0.f;
    for (int i = 0; i < n / 8; ++i) {
      u32x4 v = src[i];
#pragma unroll
      for (int e = 0; e < 4; ++e) {
        float a = __uint_as_float(v[e] << 16), b2 = __uint_as_float(v[e] & 0xffff0000u);
        ss += a * a + b2 * b2;
      }
    }
    ss += __shfl_xor(ss, 1);
    __syncthreads();
    if (part == 0) rs[r] = rsqrtf(ss / (float)(isq ? Q_LORA : KV_LORA) + EPS);
  }
  const int b = m0 / SEQ;
  if (isq) {
    const int hh = u;
    gemm128(p.proj + C_QLAT, IN_COLS, nullptr, m0, p.wq_t, Q_LORA, hh * 96, Q_LORA, smem, [&](int half, const float* sC) {
      const int l16 = tid & 15, c8 = l16 * 8;
#pragma unroll
      for (int pass = 0; pass < 4; ++pass) {
        int r = pass * 16 + (tid >> 4);
        int rg = half * 64 + r;
        float v[8];
        float rl = rs[rg];
        const float* src = sC + r * SC_LD + c8;
        float ss = 0.f;
#pragma unroll
        for (int e = 0; e < 8; ++e) { v[e] = (l16 < 12) ? src[e] * rl : 0.f; ss += v[e] * v[e]; }
        ss += __shfl_xor(ss, 1); ss += __shfl_xor(ss, 2); ss += __shfl_xor(ss, 4); ss += __shfl_xor(ss, 8);
        float rstd = rsqrtf(ss * (1.f / 96.f) + EPS);
        int tok = m0 + rg;
        const float* cs = p.cs + (size_t)tok * 32;
        int gi = (l16 < 12) ? c8 : 0;
#pragma unroll
        for (int e = 0; e < 8; ++e) v[e] = v[e] * rstd * p.qn_g[gi + e];
        float o[8];
#pragma unroll
        for (int e = 0; e < 8; ++e) {
          float other = __shfl_xor(v[e], 2);
          int i = (l16 & 1) * 8 + e;
          float cv = cs[i], sv = cs[16 + i];
          float roped = (l16 < 10) ? (v[e] * cv - other * sv) : (v[e] * cv + other * sv);
          o[e] = (l16 >= 8) ? roped : v[e];
        }
        if (l16 < 12) {
          int sidx = tok - b * SEQ;
          bf16_t* dst = p.Q + ((size_t)(b * MLA_HEADS + hh) * SEQ + sidx) * 96 + c8;
          u32x4 ov = {pack2bf(o[0], o[1]), pack2bf(o[2], o[3]), pack2bf(o[4], o[5]), pack2bf(o[6], o[7])};
          *(u32x4*)dst = ov;
        }
      }
    });
  } else {
    const int hh = u - 8;
    gemm128(p.proj + C_KVLAT, IN_COLS, nullptr, m0, p.wkv_t, KV_LORA, hh * 128, KV_LORA, smem, [&](int half, const float* sC) {
      const int l16 = tid & 15, c8 = l16 * 8;
#pragma unroll
      for (int pass = 0; pass < 4; ++pass) {
        int r = pass * 16 + (tid >> 4);
        int rg = half * 64 + r;
        int tok = m0 + rg;
        float v[8];
        float rl = rs[rg];
        const float* src = sC + r * SC_LD + c8;
#pragma unroll
        for (int e = 0; e < 8; ++e) v[e] = src[e] * rl;
        float kr[8];
        {
          const bf16_t* krp = p.proj + (size_t)tok * IN_COLS + C_KROPE + ((l16 - 8) & 3) * 8;
          u32x4 kv = *(const u32x4*)krp;
#pragma unroll
          for (int e = 0; e < 4; ++e) { kr[2 * e] = __uint_as_float(kv[e] << 16); kr[2 * e + 1] = __uint_as_float(kv[e] & 0xffff0000u); }
        }
        const bool has_nope = l16 < 8, has_rope = (l16 >= 8 && l16 < 12);
        float ss = 0.f;
#pragma unroll
        for (int e = 0; e < 8; ++e) ss += has_nope ? v[e] * v[e] : (has_rope ? kr[e] * kr[e] : 0.f);
        ss += __shfl_xor(ss, 1); ss += __shfl_xor(ss, 2); ss += __shfl_xor(ss, 4); ss += __shfl_xor(ss, 8);
        float rstd = rsqrtf(ss * (1.f / 96.f) + EPS);
        const float* cs = p.cs + (size_t)tok * 32;
        int sidx = tok - b * SEQ;
        size_t orow = (size_t)(b * MLA_HEADS + hh) * SEQ + sidx;
        if (has_nope) {
          float o[8];
#pragma unroll
          for (int e = 0; e < 8; ++e) o[e] = v[e] * rstd * p.kn_g[c8 + e];
          u32x4 ov = {pack2bf(o[0], o[1]), pack2bf(o[2], o[3]), pack2bf(o[4], o[5]), pack2bf(o[6], o[7])};
          *(u32x4*)(p.Kk + orow * 96 + c8) = ov;
        }
        {
          float kn[8], o[8];
          int d0 = ((l16 - 8) & 3) * 8;
#pragma unroll
          for (int e = 0; e < 8; ++e) kn[e] = kr[e] * rstd * p.kn_g[64 + d0 + e];
#pragma unroll
          for (int e = 0; e < 8; ++e) {
            float other = __shfl_xor(kn[e], 2);
            int i = (l16 & 1) * 8 + e;
            float cv = cs[i], sv = cs[16 + i];
            o[e] = (l16 < 10) ? (kn[e] * cv - other * sv) : (kn[e] * cv + other * sv);
          }
          if (has_rope) {
            u32x4 ov = {pack2bf(o[0], o[1]), pack2bf(o[2], o[3]), pack2bf(o[4], o[5]), pack2bf(o[6], o[7])};
            *(u32x4*)(p.Kk + orow * 96 + 64 + d0) = ov;
          }
        }
      }
      {
        int vv = tid & 63, q4 = tid >> 6;
        float t16[16];
#pragma unroll
        for (int e = 0; e < 16; ++e) t16[e] = sC[(q4 * 16 + e) * SC_LD + 64 + vv] * rs[half * 64 + q4 * 16 + e];
        int sidx0 = m0 - b * SEQ + half * 64 + q4 * 16;
        bf16_t* dst = p.V + ((size_t)(b * MLA_HEADS + hh) * 64 + vv) * SEQ + sidx0;
        u32x4 o0 = {pack2bf(t16[0], t16[1]), pack2bf(t16[2], t16[3]), pack2bf(t16[4], t16[5]), pack2bf(t16[6], t16[7])};
        u32x4 o1 = {pack2bf(t16[8], t16[9]), pack2bf(t16[10], t16[11]), pack2bf(t16[12], t16[13]), pack2bf(t16[14], t16[15])};
        *(u32x4*)dst = o0;
        *(u32x4*)(dst + 8) = o1;
      }
    });
  }
}
using f32x16 = __attribute__((ext_vector_type(16))) float;
using s16x4 = __attribute__((ext_vector_type(4))) short;
using u32x2 = __attribute__((ext_vector_type(2))) unsigned;
#define ATT_KLD 208
#define ATT_VLD 136
#define ATT_VOFF (64 * ATT_KLD)
#define MFMA32(a, b, c) __builtin_amdgcn_mfma_f32_32x32x16_bf16((a), (b), (c), 0, 0, 0)

__device__ __forceinline__ void attn_item(const Params& p, int item, char* smem) {
  int tid_ = threadIdx.x;
  asm volatile("" : "+v"(tid_));
  const int tid = tid_, lane = tid & 63, w = tid >> 6, r = lane & 31, h = lane >> 5;
  const int bh = item >> 4, qb = item & 15;
  char* sK = smem;
  char* sV = smem + ATT_VOFF;
  const bf16_t* Qp = p.Q + ((size_t)bh * SEQ + qb * 128 + w * 32 + r) * 96;
  const char* Kp = (const char*)(p.Kk + (size_t)bh * SEQ * 96);
  const char* Vp = (const char*)(p.V + (size_t)bh * 64 * SEQ);
  bf16x8 qf[6];
#pragma unroll
  for (int ks = 0; ks < 6; ++ks) qf[ks] = *(const bf16x8*)(Qp + ks * 16 + h * 8);
  f32x16 o0, o1;
#pragma unroll
  for (int i = 0; i < 16; ++i) { o0[i] = 0.f; o1[i] = 0.f; }
  float m = -1e30f, l = 0.f;
  const float c = 0.10206207261596577f * 1.4426950408889634f;
  int kgo[3], klo[3], vgo[2], vlo[2];
#pragma unroll
  for (int i = 0; i < 3; ++i) { int cc = tid + 256 * i, row = cc / 12, ch = cc % 12; kgo[i] = cc * 16; klo[i] = row * ATT_KLD + ch * 16; }
#pragma unroll
  for (int i = 0; i < 2; ++i) { int cc = tid + 256 * i, vr = cc >> 3, ch = cc & 7; vgo[i] = vr * (SEQ * 2) + ch * 16; vlo[i] = vr * ATT_VLD + ch * 16; }
  u32x4 rk[3], rv[2];
#pragma unroll
  for (int i = 0; i < 3; ++i) rk[i] = *(const u32x4*)(Kp + kgo[i]);
#pragma unroll
  for (int i = 0; i < 2; ++i) rv[i] = *(const u32x4*)(Vp + vgo[i]);

  auto stage_store = [&]() {
#pragma unroll
    for (int i = 0; i < 3; ++i) *(u32x4*)(sK + klo[i]) = rk[i];
#pragma unroll
    for (int i = 0; i < 2; ++i) {
      u32x2 lo = {rv[i][0], rv[i][1]}, hi = {rv[i][2], rv[i][3]};
      *(u32x2*)(sV + vlo[i]) = lo;
      *(u32x2*)(sV + vlo[i] + 8) = hi;
    }
  };
  auto compute = [&]() {
    f32x16 s0, s1;
#pragma unroll
    for (int i = 0; i < 16; ++i) { s0[i] = 0.f; s1[i] = 0.f; }
#pragma unroll
    for (int ks = 0; ks < 6; ++ks) {
      bf16x8 a0 = *(const bf16x8*)(sK + r * ATT_KLD + (ks * 2 + h) * 16);
      bf16x8 a1 = *(const bf16x8*)(sK + (32 + r) * ATT_KLD + (ks * 2 + h) * 16);
      s0 = MFMA32(a0, qf[ks], s0);
      s1 = MFMA32(a1, qf[ks], s1);
    }
    float mx = s0[0];
#pragma unroll
    for (int i = 1; i < 16; ++i) mx = fmaxf(mx, s0[i]);
#pragma unroll
    for (int i = 0; i < 16; ++i) mx = fmaxf(mx, s1[i]);
    mx = fmaxf(mx, __shfl_xor(mx, 32));
    float mn = fmaxf(m, mx);
    float alpha = exp2f((m - mn) * c);
    m = mn;
    float mc = mn * c;
    float ls = 0.f;
#pragma unroll
    for (int i = 0; i < 16; ++i) { s0[i] = exp2f(s0[i] * c - mc); ls += s0[i]; }
#pragma unroll
    for (int i = 0; i < 16; ++i) { s1[i] = exp2f(s1[i] * c - mc); ls += s1[i]; }
    l = l * alpha + ls;
#pragma unroll
    for (int i = 0; i < 16; ++i) { o0[i] *= alpha; o1[i] *= alpha; }
#pragma unroll
    for (int kb = 0; kb < 2; ++kb) {
#pragma unroll
      for (int s = 0; s < 2; ++s) {
        u32x4 pk;
#pragma unroll
        for (int e = 0; e < 4; ++e) {
          float a = kb ? s1[8 * s + 2 * e] : s0[8 * s + 2 * e];
          float b2 = kb ? s1[8 * s + 2 * e + 1] : s0[8 * s + 2 * e + 1];
          pk[e] = pack2bf(a, b2);
        }
        bf16x8 pf = __builtin_bit_cast(bf16x8, pk);
        int koff = (kb * 32 + 16 * s + 4 * h) * 2;
        s16x4 lo0 = *(const s16x4*)(sV + r * ATT_VLD + koff);
        s16x4 hi0 = *(const s16x4*)(sV + r * ATT_VLD + koff + 16);
        s16x4 lo1 = *(const s16x4*)(sV + (32 + r) * ATT_VLD + koff);
        s16x4 hi1 = *(const s16x4*)(sV + (32 + r) * ATT_VLD + koff + 16);
        bf16x8 v0 = __builtin_shufflevector(lo0, hi0, 0, 1, 2, 3, 4, 5, 6, 7);
        bf16x8 v1 = __builtin_shufflevector(lo1, hi1, 0, 1, 2, 3, 4, 5, 6, 7);
        o0 = MFMA32(v0, pf, o0);
        o1 = MFMA32(v1, pf, o1);
      }
    }
  };
  for (int kt = 1; kt < SEQ / 64; ++kt) {
    __syncthreads();
    stage_store();
    __syncthreads();
#pragma unroll
    for (int i = 0; i < 3; ++i) rk[i] = *(const u32x4*)(Kp + (size_t)kt * (64 * 192) + kgo[i]);
#pragma unroll
    for (int i = 0; i < 2; ++i) rv[i] = *(const u32x4*)(Vp + kt * 128 + vgo[i]);
    compute();
  }
  __syncthreads();
  stage_store();
  __syncthreads();
  compute();
  l += __shfl_xor(l, 32);
  float inv = 1.f / l;
  const int b = bh >> 3, hh = bh & 7;
  bf16_t* orow = p.mix + ((size_t)b * SEQ + qb * 128 + w * 32 + r) * D_MODEL + hh * 64;
#pragma unroll
  for (int g = 0; g < 4; ++g) {
    u32x2 w0 = {pack2bf(o0[4 * g] * inv, o0[4 * g + 1] * inv), pack2bf(o0[4 * g + 2] * inv, o0[4 * g + 3] * inv)};
    u32x2 w1 = {pack2bf(o1[4 * g] * inv, o1[4 * g + 1] * inv), pack2bf(o1[4 * g + 2] * inv, o1[4 * g + 3] * inv)};
    *(u32x2*)(orow + 8 * g + 4 * h) = w0;
    *(u32x2*)(orow + 32 + 8 * g + 4 * h) = w1;
  }
}
#define HG_QD 0
#define HG_KD 17408
#define HG_KRT 34816
#define HG_VT 53248
#define HG_DL 71680
#define HG_PRE 72192
#define HG_SMEM 73216
#define HG_OT 0

__device__ __forceinline__ void hgrn_item(const Params& p, int item, char* smem) {
  const int DIR = item & 1, hh = (item >> 1) & 3, b = item >> 3;
  __syncthreads();
  int tid_ = threadIdx.x;
  asm volatile("" : "+v"(tid_));
  const int tid = tid_, lane = tid & 63, w = tid >> 6, r = lane & 31, h = lane >> 5;
  char* sQD = smem + HG_QD; char* sKD = smem + HG_KD; char* sKRT = smem + HG_KRT; char* sVT = smem + HG_VT;
  float* dl = (float*)(smem + HG_DL); float* pre = (float*)(smem + HG_PRE); float* sOT = (float*)(smem + HG_OT);
  f32x16 S[4];
#pragma unroll
  for (int kt = 0; kt < 4; ++kt)
#pragma unroll
    for (int i = 0; i < 16; ++i) S[kt][i] = 0.f;
  const int k = tid & 127, part = tid >> 7;
  const int fcol = DIR ? C_HFB : C_HFF;
  const float lbv = p.lb[DIR * HG_W + hh * 128 + k];
  bf16_t* odir = p.of16 + (size_t)DIR * NTOK * HG_W;
  const bf16_t* hiT_bh = p.hiT + (size_t)(b * HG_HEADS + hh) * HG_DIM * SEQ;
  for (int n = 0; n < SEQ / 64; ++n) {
    const int cn = DIR ? (SEQ / 64 - 1 - n) : n;
    const size_t tok0 = (size_t)b * SEQ + cn * 64;
#pragma unroll
    for (int i = 0; i < 4; ++i) {
      int cc = tid + 256 * i, c = cc >> 4, ch = cc & 15;
      const bf16_t* rowp = p.proj + (tok0 + c) * IN_COLS + hh * 128 + ch * 8;
      *(u32x4*)(sQD + c * 272 + ch * 16) = *(const u32x4*)(rowp + C_HQ);
      *(u32x4*)(sKD + c * 272 + ch * 16) = *(const u32x4*)(rowp + fcol);
      int v = cc >> 3, ch8 = cc & 7;
      *(u32x4*)(sVT + v * 144 + ch8 * 16) = *(const u32x4*)(hiT_bh + (size_t)v * SEQ + cn * 64 + ch8 * 8);
    }
    unsigned pf0 = 0, pf1 = 0;
    if (n + 1 < SEQ / 64) {
      const int cn2 = DIR ? cn - 1 : cn + 1;
      const size_t tokn = (size_t)b * SEQ + cn2 * 64;
      const int c = tid >> 2, sub = tid & 3;
      pf0 = *(const unsigned*)(p.proj + (tokn + c) * IN_COLS + hh * 128 + ((sub & 2) ? fcol : C_HQ) + (sub & 1) * 64);
      if (tid < 128) pf1 = *(const unsigned*)(hiT_bh + (size_t)tid * SEQ + cn2 * 64);
    }
    __syncthreads();
    {
      const float L2E = 1.4426950408889634f;
      const float oml = 1.f - lbv;
      float lf[32];
#pragma unroll
      for (int i = 0; i < 32; i += 2) {
        bf16_t* zp0 = (bf16_t*)(sKD + (32 * part + i) * 272 + k * 2);
        bf16_t* zp1 = (bf16_t*)(sKD + (32 * part + i + 1) * 272 + k * 2);
        float z0 = bf2f(*zp0), z1 = bf2f(*zp1);
        float om0 = oml * __builtin_amdgcn_rcpf(1.f + __builtin_amdgcn_exp2f(z0 * L2E));
        float om1 = oml * __builtin_amdgcn_rcpf(1.f + __builtin_amdgcn_exp2f(z1 * L2E));
        lf[i] = __builtin_amdgcn_logf(1.f - om0);
        lf[i + 1] = __builtin_amdgcn_logf(1.f - om1);
        unsigned pk = pack2bf(om0, om1);
        *zp0 = (bf16_t)(pk & 0xffffu);
        *zp1 = (bf16_t)(pk >> 16);
      }
      if (DIR == 0) {
#pragma unroll
        for (int i = 1; i < 32; ++i) lf[i] += lf[i - 1];
      } else {
#pragma unroll
        for (int i = 30; i >= 0; --i) lf[i] += lf[i + 1];
      }
      const float tot = DIR ? lf[0] : lf[31];
      pre[part * 128 + k] = tot;
      __syncthreads();
      const float other = pre[(part ^ 1) * 128 + k];
      const float btot = tot + other;
      const float off = (DIR == 0) ? (part == 1 ? other : 0.f) : (part == 0 ? other : 0.f);
      const float ebtot = __builtin_amdgcn_exp2f(btot);
      if (part == 0) dl[k] = ebtot;
#pragma unroll
      for (int q = 0; q < 4; ++q) {
        float kr8[8];
#pragma unroll
        for (int u = 0; u < 8; u += 2) {
          const int i = q * 8 + u, c = 32 * part + i;
          bf16_t* kp0 = (bf16_t*)(sKD + c * 272 + k * 2);
          bf16_t* kp1 = (bf16_t*)(sKD + (c + 1) * 272 + k * 2);
          bf16_t* qp0 = (bf16_t*)(sQD + c * 272 + k * 2);
          bf16_t* qp1 = (bf16_t*)(sQD + (c + 1) * 272 + k * 2);
          float kk0 = bf2f(*kp0), kk1 = bf2f(*kp1), zq0 = bf2f(*qp0), zq1 = bf2f(*qp1);
          float bb0 = lf[i] + off, bb1 = lf[i + 1] + off;
          float eb0 = __builtin_amdgcn_exp2f(bb0), eb1 = __builtin_amdgcn_exp2f(bb1);
          float kd0 = kk0 * __builtin_amdgcn_exp2f(-bb0), kd1 = kk1 * __builtin_amdgcn_exp2f(-bb1);
          float qd0 = zq0 * __builtin_amdgcn_rcpf(1.f + __builtin_amdgcn_exp2f(-zq0 * L2E)) * eb0;
          float qd1 = zq1 * __builtin_amdgcn_rcpf(1.f + __builtin_amdgcn_exp2f(-zq1 * L2E)) * eb1;
          kr8[u] = kd0 * ebtot; kr8[u + 1] = kd1 * ebtot;
          unsigned pq = pack2bf(qd0, qd1), pk2 = pack2bf(kd0, kd1);
          *qp0 = (bf16_t)(pq & 0xffffu); *qp1 = (bf16_t)(pq >> 16);
          *kp0 = (bf16_t)(pk2 & 0xffffu); *kp1 = (bf16_t)(pk2 >> 16);
        }
        u32x4 o = {pack2bf(kr8[0], kr8[1]), pack2bf(kr8[2], kr8[3]), pack2bf(kr8[4], kr8[5]), pack2bf(kr8[6], kr8[7])};
        *(u32x4*)(sKRT + k * 144 + part * 64 + q * 16) = o;
      }
    }
    __syncthreads();
    {
      const int cb = w >> 1, sb = w & 1;
      const bool skip = DIR ? (cb == 1 && sb == 0) : (cb == 0 && sb == 1);
      f32x16 acc;
#pragma unroll
      for (int i = 0; i < 16; ++i) acc[i] = 0.f;
      if (!skip) {
#pragma unroll
        for (int ks = 0; ks < 8; ++ks) {
          bf16x8 a = *(const bf16x8*)(sQD + (cb * 32 + r) * 272 + (ks * 2 + h) * 16);
          bf16x8 bb = *(const bf16x8*)(sKD + (sb * 32 + r) * 272 + (ks * 2 + h) * 16);
          acc = MFMA32(a, bb, acc);
        }
      }
      __syncthreads();
#pragma unroll
      for (int i = 0; i < 16; ++i) {
        int c = cb * 32 + (i & 3) + 8 * (i >> 2) + 4 * h, s = sb * 32 + r;
        bool keep = DIR ? (s >= c) : (s <= c);
        *(bf16_t*)(sKD + c * 144 + s * 2) = f2bf(keep ? acc[i] : 0.f);
      }
    }
    __syncthreads();
    f32x16 oc[2];
#pragma unroll
    for (int cb = 0; cb < 2; ++cb)
#pragma unroll
      for (int i = 0; i < 16; ++i) oc[cb][i] = 0.f;
#pragma unroll
    for (int kt = 0; kt < 4; ++kt) {
#pragma unroll
      for (int s = 0; s < 2; ++s) {
        u32x4 pk;
#pragma unroll
        for (int e = 0; e < 4; ++e) pk[e] = pack2bf(S[kt][8 * s + 2 * e], S[kt][8 * s + 2 * e + 1]);
        bf16x8 pf = __builtin_bit_cast(bf16x8, pk);
        int kof = (kt * 32 + 16 * s + 4 * h) * 2;
#pragma unroll
        for (int cb = 0; cb < 2; ++cb) {
          s16x4 lo = *(const s16x4*)(sQD + (cb * 32 + r) * 272 + kof);
          s16x4 hi = *(const s16x4*)(sQD + (cb * 32 + r) * 272 + kof + 16);
          bf16x8 a = __builtin_shufflevector(lo, hi, 0, 1, 2, 3, 4, 5, 6, 7);
          oc[cb] = MFMA32(a, pf, oc[cb]);
        }
      }
    }
#pragma unroll
    for (int st = 0; st < 4; ++st) {
      bf16x8 bv = *(const bf16x8*)(sVT + (w * 32 + r) * 144 + (st * 2 + h) * 16);
#pragma unroll
      for (int cb = 0; cb < 2; ++cb) {
        bf16x8 a = *(const bf16x8*)(sKD + (cb * 32 + r) * 144 + (st * 2 + h) * 16);
        oc[cb] = MFMA32(a, bv, oc[cb]);
      }
    }
#pragma unroll
    for (int kt = 0; kt < 4; ++kt) {
#pragma unroll
      for (int g = 0; g < 4; ++g) {
        float4 d4 = *(const float4*)(dl + kt * 32 + 8 * g + 4 * h);
        S[kt][4 * g] *= d4.x; S[kt][4 * g + 1] *= d4.y; S[kt][4 * g + 2] *= d4.z; S[kt][4 * g + 3] *= d4.w;
      }
#pragma unroll
      for (int st = 0; st < 4; ++st) {
        bf16x8 a = *(const bf16x8*)(sKRT + (kt * 32 + r) * 144 + (st * 2 + h) * 16);
        bf16x8 bv = *(const bf16x8*)(sVT + (w * 32 + r) * 144 + (st * 2 + h) * 16);
        S[kt] = MFMA32(a, bv, S[kt]);
      }
    }
    __syncthreads();
#pragma unroll
    for (int cb = 0; cb < 2; ++cb)
#pragma unroll
      for (int i = 0; i < 16; ++i) sOT[(cb * 32 + (i & 3) + 8 * (i >> 2) + 4 * h) * 132 + w * 32 + r] = oc[cb][i];
    __syncthreads();
    {
      const int c = tid >> 2, qd = tid & 3;
      const float* src = sOT + c * 132 + qd * 32;
      bf16_t* ofp = odir + (tok0 + c) * HG_W + hh * 128 + qd * 32;
#pragma unroll
      for (int q = 0; q < 4; ++q) {
        float4 v0 = *(const float4*)(src + q * 8), v1 = *(const float4*)(src + q * 8 + 4);
        u32x4 o = {pack2bf(v0.x, v0.y), pack2bf(v0.z, v0.w), pack2bf(v1.x, v1.y), pack2bf(v1.z, v1.w)};
        *(u32x4*)(ofp + q * 8) = o;
      }
    }
    if (pf0 == 0x7fc12345u && pf1 == 0x7fc54321u) p.qctr[3] = 1;
    __syncthreads();
  }
  asm volatile("s_waitcnt vmcnt(0)" ::: "memory");
  __syncthreads();
  int* tk = (int*)(smem + HG_PRE);
  if (tid == 0) {
    __builtin_amdgcn_fence(__ATOMIC_RELEASE, "agent");
    asm volatile("s_waitcnt vmcnt(0)" ::: "memory");
    int old = __hip_atomic_fetch_add(&p.hcnt[b * HG_HEADS + hh], 1, __ATOMIC_RELAXED, __HIP_MEMORY_SCOPE_AGENT);
    if (old == 1) {
      __builtin_amdgcn_fence(__ATOMIC_ACQUIRE, "agent");
      asm volatile("s_waitcnt vmcnt(0)" ::: "memory");
    }
    *tk = old;
  }
  __syncthreads();
  if (*tk == 1) {
    const int qd = tid & 3;
    const float4* ngp = (const float4*)(p.hg_norm_g + qd * 32);
    for (int pass = 0; pass < SEQ / 64; ++pass) {
      const size_t tok = (size_t)b * SEQ + pass * 64 + (tid >> 2);
      const bf16_t* f0 = p.of16 + tok * HG_W + hh * 128 + qd * 32;
      const bf16_t* f1 = f0 + (size_t)NTOK * HG_W;
      const bf16_t* hgp = p.proj + tok * IN_COLS + C_HG + hh * 128 + qd * 32;
      u32x4 a4[4], b4[4], g4[4];
#pragma unroll
      for (int q = 0; q < 4; ++q) { a4[q] = *(const u32x4*)(f0 + q * 8); b4[q] = *(const u32x4*)(f1 + q * 8); g4[q] = *(const u32x4*)(hgp + q * 8); }
      float ov[32];
      float ss = 0.f;
#pragma unroll
      for (int q = 0; q < 4; ++q)
#pragma unroll
        for (int e = 0; e < 4; ++e) {
          float lo = __uint_as_float(a4[q][e] << 16) + __uint_as_float(b4[q][e] << 16);
          float hi = __uint_as_float(a4[q][e] & 0xffff0000u) + __uint_as_float(b4[q][e] & 0xffff0000u);
          ov[q * 8 + 2 * e] = lo; ov[q * 8 + 2 * e + 1] = hi;
          ss += lo * lo + hi * hi;
        }
      ss += __shfl_xor(ss, 1); ss += __shfl_xor(ss, 2);
      const float rstd = rsqrtf(ss * (1.f / 128.f) + EPS);
      bf16_t* dst = p.mix + tok * D_MODEL + 512 + hh * 128 + qd * 32;
#pragma unroll
      for (int q = 0; q < 4; ++q) {
        float4 n0 = ngp[q * 2], n1 = ngp[q * 2 + 1];
        float ng[8] = {n0.x, n0.y, n0.z, n0.w, n1.x, n1.y, n1.z, n1.w};
        float res[8];
#pragma unroll
        for (int e = 0; e < 4; ++e) {
          float g0 = __uint_as_float(g4[q][e] << 16), g1 = __uint_as_float(g4[q][e] & 0xffff0000u);
          res[2 * e] = ov[q * 8 + 2 * e] * rstd * ng[2 * e] * silu_f(g0);
          res[2 * e + 1] = ov[q * 8 + 2 * e + 1] * rstd * ng[2 * e + 1] * silu_f(g1);
        }
        u32x4 o = {pack2bf(res[0], res[1]), pack2bf(res[2], res[3]), pack2bf(res[4], res[5]), pack2bf(res[6], res[7])};
        *(u32x4*)(dst + q * 8) = o;
      }
    }
  }
}
__device__ __forceinline__ bool moe_tile(const int* cnt, int tile, int rows_per_tile, int& e, int& r0, int& nrows) {
  int acc = 0;
  for (int i = 0; i < N_EXP; ++i) {
    int c = cnt[i * CNT_STRIDE];
    int nt = (c + rows_per_tile - 1) / rows_per_tile;
    if (tile < acc + nt) { e = i; r0 = (tile - acc) * rows_per_tile; nrows = min(rows_per_tile, c - r0); return true; }
    acc += nt;
  }
  return false;
}


__device__ __forceinline__ void moe_up_tile(const Params& p, int e, int r0, int nrows, int nb, char* smem) {
  const int tid = otid();
  int* arow = (int*)(smem + SMEM_EXTRA_OFF);
  int* aasg = arow + 128;
  __syncthreads();
  if (tid < 128) {
    int a = (tid < nrows) ? p.list[e * 65536 + r0 + tid] : -1;
    aasg[tid] = a;
    arow[tid] = (a >= 0) ? (a >> 1) : -1;
  }
  __syncthreads();
  gemm128(p.h, D_MODEL, arow, 0, p.wgu_t + (size_t)e * 1024 * 1024, D_MODEL, nb * 128, D_MODEL, smem, [&](int half, const float* sC) {
    int c4 = (tid & 15) * 4;
#pragma unroll
    for (int pass = 0; pass < 4; ++pass) {
      int r = pass * 16 + (tid >> 4);
      int a = aasg[half * 64 + r];
      if (a >= 0) {
        const float* src = sC + r * SC_LD + c4;
        float4 g = *(const float4*)src, uu = *(const float4*)(src + 64);
        uint2 o;
        o.x = pack2bf(silu_f(g.x) * uu.x, silu_f(g.y) * uu.y);
        o.y = pack2bf(silu_f(g.z) * uu.z, silu_f(g.w) * uu.w);
        *(uint2*)(p.hid + (size_t)a * D_EXP + nb * 64 + c4) = o;
      }
    }
  });
}
__device__ __forceinline__ void moe_down_tile(const Params& p, int e, int r0, int nrows, int nb, char* smem) {
  const int tid = otid();
  int* arow = (int*)(smem + SMEM_EXTRA_OFF);
  __syncthreads();
  if (tid < 128) arow[tid] = (tid < nrows) ? p.list[e * 65536 + r0 + tid] : -1;
  __syncthreads();
  gemm128(p.hid, D_EXP, arow, 0, p.wd_t + (size_t)e * 1024 * 512, D_EXP, nb * 128, D_EXP, smem, [&](int half, const float* sC) {
    int c8 = (tid & 15) * 8;
#pragma unroll
    for (int pass = 0; pass < 4; ++pass) {
      int r = pass * 16 + (tid >> 4);
      int a = arow[half * 64 + r];
      if (a >= 0) {
        const float* src = sC + r * SC_LD + c8;
        float4 v0 = *(const float4*)src, v1 = *(const float4*)(src + 4);
        u32x4 o = {pack2bf(v0.x, v0.y), pack2bf(v0.z, v0.w), pack2bf(v1.x, v1.y), pack2bf(v1.z, v1.w)};
        *(u32x4*)(p.y + (size_t)a * D_MODEL + nb * 128 + c8) = o;
      }
    }
  });
}
#define XB_TMO      128
#define XB_XCNT(j)  (256  + 64 * (j))
#define XB_XSUB(j)  (1280 + 64 * (j))
#define XB_XGEN(j)  (2304 + 64 * (j))
#define XB_TOP      3328
#define XB_TOPGEN   3392
#define XCD_BAR_WORDS 3456
#define XB_SPIN_CAP (1u << 20)
#define LAS __attribute__((address_space(3)))
__device__ __forceinline__ unsigned xb_ld(unsigned* p)              { return __hip_atomic_load(p, __ATOMIC_RELAXED, __HIP_MEMORY_SCOPE_AGENT); }
__device__ __forceinline__ unsigned xb_add(unsigned* p, unsigned v) { return __hip_atomic_fetch_add(p, v, __ATOMIC_RELAXED, __HIP_MEMORY_SCOPE_AGENT); }
__device__ __forceinline__ unsigned xb_xcc_id() { return (unsigned)__builtin_amdgcn_s_getreg((3 << 11) | 20) & 0xFu; }
#define XB_SPIN(cond, bar) do { unsigned _sp = 0; while (cond) { __builtin_amdgcn_s_sleep(1); \
    if ((++_sp & 255u) == 0u) { if (xb_ld(&(bar)[XB_TMO])) break; if (_sp > XB_SPIN_CAP) { atomicAdd(&(bar)[XB_TMO], 1u); break; } } } } while (0)
struct XcdBarrier { unsigned* bar; unsigned x; volatile LAS unsigned* st; };
__device__ __forceinline__ XcdBarrier xcd_barrier_post(unsigned* bar, volatile LAS unsigned* st) {
  XcdBarrier b; b.bar = bar; b.x = xb_xcc_id(); b.st = st;
  if (threadIdx.x == 0) (void)xb_add(&bar[XB_XCNT(b.x)], 1u);
  return b;
}
__device__ __forceinline__ void xcd_barrier_complete(unsigned* bar, unsigned x, unsigned& nloc, unsigned& nx) {
  const unsigned G = gridDim.x * gridDim.y * gridDim.z;
  unsigned sum, cnt, mine, sp = 0u;
  for (;;) {
    sum = 0u; cnt = 0u; mine = 0u;
#pragma unroll
    for (unsigned j = 0; j < 16; ++j) { const unsigned c = xb_ld(&bar[XB_XCNT(j)]); sum += c; cnt += (c > 0u) ? 1u : 0u; mine = (j == x) ? c : mine; }
    if (sum == G) break;
    __builtin_amdgcn_s_sleep(1);
    if ((++sp & 255u) == 0u) { if (xb_ld(&bar[XB_TMO])) break; if (sp > XB_SPIN_CAP) { atomicAdd(&bar[XB_TMO], 1u); break; } }
  }
  nloc = mine > 0u ? mine : 1u; nx = cnt > 0u ? cnt : 1u;
}
__device__ __forceinline__ void xcd_barrier(const XcdBarrier& b) {
  asm volatile("s_waitcnt vmcnt(0)" ::: "memory");
  __syncthreads();
  if (threadIdx.x == 0) {
    unsigned* bar = b.bar;
    __builtin_amdgcn_s_waitcnt(0);
    unsigned nloc = b.st[0], nx = b.st[1];
    if (nloc == 0u) { xcd_barrier_complete(bar, b.x, nloc, nx); b.st[0] = nloc; b.st[1] = nx; }
    const unsigned old = xb_add(&bar[XB_XSUB(b.x)], 1u);
    const unsigned gen = old / nloc;
    if (old + 1u == (gen + 1u) * nloc) {
      __builtin_amdgcn_fence(__ATOMIC_RELEASE, "agent");
      asm volatile("s_waitcnt vmcnt(0)" ::: "memory");
      const unsigned og = xb_add(&bar[XB_TOP], 1u);
      const unsigned tg = og / nx;
      if (og + 1u == (tg + 1u) * nx) xb_add(&bar[XB_TOPGEN], 1u);
      else XB_SPIN(xb_ld(&bar[XB_TOPGEN]) == tg, bar);
      __builtin_amdgcn_fence(__ATOMIC_ACQUIRE, "agent");
      xb_add(&bar[XB_XGEN(b.x)], 1u);
      asm volatile("s_waitcnt vmcnt(0)" ::: "memory");
    } else {
      XB_SPIN(xb_ld(&bar[XB_XGEN(b.x)]) == gen, bar);
      __builtin_amdgcn_fence(__ATOMIC_ACQUIRE, "agent");
      asm volatile("s_waitcnt vmcnt(0)" ::: "memory");
    }
  }
  __syncthreads();
}

__device__ __forceinline__ void mod_item(const Params& p, int item, char* smem) {
  const int tid = otid(), col = tid & 31, kg = tid >> 5, n0 = item * 32;
  float* ca = (float*)smem;
  __syncthreads();
  for (int e = tid; e < 16 * 1024; e += 256) {
    int b = e >> 10, k = e & 1023;
    ca[k * 16 + b] = silu_f(p.c[b * D_MODEL + k]);
  }
  __syncthreads();
  float acc[16];
#pragma unroll
  for (int b = 0; b < 16; ++b) acc[b] = 0.f;
  const float* wp = p.ada_w + (size_t)(kg * 128) * 6144 + n0 + col;
#pragma unroll 4
  for (int kk = 0; kk < 128; ++kk) {
    float wv = wp[(size_t)kk * 6144];
    const float4* cp = (const float4*)(ca + (kg * 128 + kk) * 16);
    float4 c0 = cp[0], c1 = cp[1], c2 = cp[2], c3 = cp[3];
    acc[0] += c0.x * wv; acc[1] += c0.y * wv; acc[2] += c0.z * wv; acc[3] += c0.w * wv;
    acc[4] += c1.x * wv; acc[5] += c1.y * wv; acc[6] += c1.z * wv; acc[7] += c1.w * wv;
    acc[8] += c2.x * wv; acc[9] += c2.y * wv; acc[10] += c2.z * wv; acc[11] += c2.w * wv;
    acc[12] += c3.x * wv; acc[13] += c3.y * wv; acc[14] += c3.z * wv; acc[15] += c3.w * wv;
  }
  __syncthreads();
  float* red = (float*)smem;
#pragma unroll
  for (int b = 0; b < 16; ++b) red[(kg * 16 + b) * 32 + col] = acc[b];
  __syncthreads();
  for (int o = tid; o < 512; o += 256) {
    int b = o >> 5, cc = o & 31;
    float s = p.ada_b[n0 + cc];
#pragma unroll
    for (int g = 0; g < 8; ++g) s += red[(g * 16 + b) * 32 + cc];
    p.mod[b * 6144 + n0 + cc] = s;
  }
}

__device__ __forceinline__ void misc_phase(const Params& p, int gtid, int gthreads) {
  for (int i = gtid; i < NTOK * 16; i += gthreads) {
    if (i < 2 * HG_W) {
      int d = i / HG_W, w = i % HG_W;
      float l0 = p.lb_logits[(d * 2 + 0) * HG_W + w], l1 = p.lb_logits[(d * 2 + 1) * HG_W + w];
      float m = fmaxf(l0, l1);
      float e0 = expf(l0 - m), e1 = expf(l1 - m);
      p.lb[i] = e0 / (e0 + e1);
    }
    int t = i >> 4, j = i & 15;
    float inv = powf(10000.0f, -(float)j / 16.0f);
    float ang = (float)p.pos[t] * inv;
    p.cs[t * 32 + j] = cosf(ang);
    p.cs[t * 32 + 16 + j] = sinf(ang);
    if (i < N_EXP) p.cnt[i * CNT_STRIDE] = 0;
    if (i < 4) p.qctr[i] = 0;
    if (i < 64) p.hcnt[i] = 0;
    if (i < 48 * 1024) {
      int row = i >> 10, kk = i & 1023;
      p.rwt[i] = row < 32 ? p.re_w[kk * 32 + row] : (row < 36 ? p.rg_w[kk * 4 + (row - 32)] : 0.f);
    }
  }
}

__device__ __forceinline__ void norm1_row(const Params& p, int t, float* red) {
  const int tid = otid(), b = t / SEQ;
  const float4 xv = ((const float4*)(p.x + (size_t)t * D_MODEL))[tid];
  float ss = xv.x * xv.x + xv.y * xv.y + xv.z * xv.z + xv.w * xv.w;
  ss = block_sum256(ss, red);
  float rstd = rsqrtf(ss * (1.f / D_MODEL) + EPS);
  int c0 = tid * 4;
  const float4 sh = *(const float4*)(p.mod + b * 6144 + c0), sc = *(const float4*)(p.mod + b * 6144 + 1024 + c0);
  const float4 g = *(const float4*)(p.norm1_g + c0);
  uint2 o;
  o.x = pack2bf(xv.x * rstd * g.x * (1.f + sc.x) + sh.x, xv.y * rstd * g.y * (1.f + sc.y) + sh.y);
  o.y = pack2bf(xv.z * rstd * g.z * (1.f + sc.z) + sh.z, xv.w * rstd * g.w * (1.f + sc.w) + sh.w);
  ((uint2*)(p.h + (size_t)t * D_MODEL))[tid] = o;
}

#define RT_LD 1028
__device__ __forceinline__ void route_group(const Params& p, int grp, char* smem) {
  const int tid = otid(), lane = tid & 63, w = tid >> 6;
  float* h2s = (float*)smem;
  float* part = (float*)(smem + 8 * RT_LD * 4);
  const int t0 = grp * 8, b = t0 / SEQ;
  __syncthreads();
#pragma unroll
  for (int tt = 0; tt < 2; ++tt) {
    const int tl = w * 2 + tt, t = t0 + tl;
    float4 xv[4];
    float ss = 0.f;
#pragma unroll
    for (int i = 0; i < 4; ++i) {
      xv[i] = *(const float4*)(p.out + (size_t)t * D_MODEL + lane * 4 + 256 * i);
      ss += xv[i].x * xv[i].x + xv[i].y * xv[i].y + xv[i].z * xv[i].z + xv[i].w * xv[i].w;
    }
    ss = wave_sum(ss);
    const float rstd = rsqrtf(ss * (1.f / D_MODEL) + EPS);
#pragma unroll
    for (int i = 0; i < 4; ++i) {
      const int c0 = lane * 4 + 256 * i;
      const float4 g = *(const float4*)(p.norm2_g + c0);
      const float4 sh = *(const float4*)(p.mod + b * 6144 + 3072 + c0);
      const float4 sc = *(const float4*)(p.mod + b * 6144 + 4096 + c0);
      float4 hv;
      hv.x = xv[i].x * rstd * g.x * (1.f + sc.x) + sh.x;
      hv.y = xv[i].y * rstd * g.y * (1.f + sc.y) + sh.y;
      hv.z = xv[i].z * rstd * g.z * (1.f + sc.z) + sh.z;
      hv.w = xv[i].w * rstd * g.w * (1.f + sc.w) + sh.w;
      uint2 o; o.x = pack2bf(hv.x, hv.y); o.y = pack2bf(hv.z, hv.w);
      *(uint2*)(p.h + (size_t)t * D_MODEL + c0) = o;
      *(float4*)(h2s + tl * RT_LD + c0) = hv;
    }
  }
  __syncthreads();
  {
    const int j16 = lane & 15, q = lane >> 4;
    f32x4 acc0 = {0.f, 0.f, 0.f, 0.f}, acc1 = acc0, acc2 = acc0;
    const float* ap = h2s + (lane & 7) * RT_LD + w * 256 + 4 * q;
    const float* bp = p.rwt + (size_t)j16 * 1024 + w * 256 + 4 * q;
#pragma unroll 4
    for (int kb = 0; kb < 16; ++kb) {
      const float4 a4 = *(const float4*)(ap + kb * 16);
      const float4 b0 = *(const float4*)(bp + kb * 16);
      const float4 b1 = *(const float4*)(bp + 16 * 1024 + kb * 16);
      const float4 b2 = *(const float4*)(bp + 32 * 1024 + kb * 16);
      acc0 = __builtin_amdgcn_mfma_f32_16x16x4f32(a4.x, b0.x, acc0, 0, 0, 0);
      acc1 = __builtin_amdgcn_mfma_f32_16x16x4f32(a4.x, b1.x, acc1, 0, 0, 0);
      acc2 = __builtin_amdgcn_mfma_f32_16x16x4f32(a4.x, b2.x, acc2, 0, 0, 0);
      acc0 = __builtin_amdgcn_mfma_f32_16x16x4f32(a4.y, b0.y, acc0, 0, 0, 0);
      acc1 = __builtin_amdgcn_mfma_f32_16x16x4f32(a4.y, b1.y, acc1, 0, 0, 0);
      acc2 = __builtin_amdgcn_mfma_f32_16x16x4f32(a4.y, b2.y, acc2, 0, 0, 0);
      acc0 = __builtin_amdgcn_mfma_f32_16x16x4f32(a4.z, b0.z, acc0, 0, 0, 0);
      acc1 = __builtin_amdgcn_mfma_f32_16x16x4f32(a4.z, b1.z, acc1, 0, 0, 0);
      acc2 = __builtin_amdgcn_mfma_f32_16x16x4f32(a4.z, b2.z, acc2, 0, 0, 0);
      acc0 = __builtin_amdgcn_mfma_f32_16x16x4f32(a4.w, b0.w, acc0, 0, 0, 0);
      acc1 = __builtin_amdgcn_mfma_f32_16x16x4f32(a4.w, b1.w, acc1, 0, 0, 0);
      acc2 = __builtin_amdgcn_mfma_f32_16x16x4f32(a4.w, b2.w, acc2, 0, 0, 0);
    }
    if (q < 2) {
#pragma unroll
      for (int r = 0; r < 4; ++r) {
        float* pr = part + (w * 8 + 4 * q + r) * 48 + j16;
        pr[0] = acc0[r]; pr[16] = acc1[r]; pr[32] = acc2[r];
      }
    }
  }
  __syncthreads();
  if (tid < 8) {
    const int t = t0 + tid;
    float gl0 = p.rg_b[0], gl1 = p.rg_b[1], gl2 = p.rg_b[2], gl3 = p.rg_b[3];
#pragma unroll
    for (int ws = 0; ws < 4; ++ws) {
      const float* pp = part + (ws * 8 + tid) * 48 + 32;
      gl0 += pp[0]; gl1 += pp[1]; gl2 += pp[2]; gl3 += pp[3];
    }
    float gm = gl0; int gi = 0;
    if (gl1 > gm) { gm = gl1; gi = 1; }
    if (gl2 > gm) { gm = gl2; gi = 2; }
    if (gl3 > gm) { gm = gl3; gi = 3; }
    const float gs = expf(gl0 - gm) + expf(gl1 - gm) + expf(gl2 - gm) + expf(gl3 - gm);
    const float gp = 1.f / gs;
    float v1 = -1e30f, v2 = -1e30f; int i1 = 0, i2 = 0;
    for (int e8 = 0; e8 < 8; ++e8) {
      const int e = gi * 8 + e8;
      float l = p.re_b[e];
#pragma unroll
      for (int ws = 0; ws < 4; ++ws) l += part[(ws * 8 + tid) * 48 + e];
      if (l > v1) { v2 = v1; i2 = i1; v1 = l; i1 = e; }
      else if (l > v2) { v2 = l; i2 = e; }
    }
    const float e2 = expf(v2 - v1);
    const float w1 = gp / (1.f + e2), w2 = gp * e2 / (1.f + e2);
    p.ewt[t * 2] = w1; p.ewt[t * 2 + 1] = w2;
    int p1 = atomicAdd(&p.cnt[i1 * CNT_STRIDE], 1); p.list[i1 * 65536 + p1] = t * 2;
    int p2 = atomicAdd(&p.cnt[i2 * CNT_STRIDE], 1); p.list[i2 * 65536 + p2] = t * 2 + 1;
  }
}

__device__ __forceinline__ void final_row(const Params& p, int t) {
  const int tid = otid(), b = t / SEQ, c0 = tid * 4;
  float w0 = p.ewt[t * 2], w1 = p.ewt[t * 2 + 1];
  float4 xv = ((const float4*)(p.out + (size_t)t * D_MODEL))[tid];
  uint2 y0 = ((const uint2*)(p.y + (size_t)(2 * t) * D_MODEL))[tid];
  uint2 y1 = ((const uint2*)(p.y + (size_t)(2 * t + 1) * D_MODEL))[tid];
  const float4 g2 = *(const float4*)(p.mod + b * 6144 + 5120 + c0);
  xv.x += g2.x * (w0 * __uint_as_float(y0.x << 16) + w1 * __uint_as_float(y1.x << 16));
  xv.y += g2.y * (w0 * __uint_as_float(y0.x & 0xffff0000u) + w1 * __uint_as_float(y1.x & 0xffff0000u));
  xv.z += g2.z * (w0 * __uint_as_float(y0.y << 16) + w1 * __uint_as_float(y1.y << 16));
  xv.w += g2.w * (w0 * __uint_as_float(y0.y & 0xffff0000u) + w1 * __uint_as_float(y1.y & 0xffff0000u));
  ((float4*)(p.out + (size_t)t * D_MODEL))[tid] = xv;
}

#ifndef XREP_P0
#define XREP_P0 0
#endif
#ifndef XREP_P1
#define XREP_P1 0
#endif
#ifndef XREP_P2
#define XREP_P2 0
#endif
#ifndef XREP_P3
#define XREP_P3 0
#endif
#ifndef XREP_ATT
#define XREP_ATT 0
#endif
#ifndef XREP_HG
#define XREP_HG 0
#endif
#ifndef XREP_P5
#define XREP_P5 0
#endif
#ifndef XREP_MOE
#define XREP_MOE 0
#endif
#define N_HG_ITEMS (BATCH * HG_HEADS * 2)
#define N_ATT_ITEMS (BATCH * MLA_HEADS * 16)

__global__ void __launch_bounds__(256, 2) k_mega(Params p) {
  cg::grid_group grid = cg::this_grid();
  __shared__ __attribute__((aligned(16))) char smem[HG_SMEM + 64];
  const int nb = gridDim.x, bid = blockIdx.x, tid = threadIdx.x;
  volatile LAS unsigned* xst = (volatile LAS unsigned*)(smem + HG_SMEM + 32);
  if (tid == 0) { xst[0] = 0u; xst[1] = 0u; }
  __syncthreads();
  const XcdBarrier xb = xcd_barrier_post(p.bar, xst);
  float* red = (float*)(smem + 65536);
  misc_phase(p, bid * 256 + tid, nb * 256);
  for (int it = bid; it < 6144 / 32; it += nb) mod_item(p, it, smem);
  __syncthreads();
  for (int job = nb - 1 - bid; job < CVT_TOTAL; job += nb) cvt_job(p, job, (float*)smem);
  grid.sync();
  for (int rep = 0; rep < XREP_P0; ++rep) {
    for (int it = bid; it < 6144 / 32; it += nb) mod_item(p, it, smem);
    __syncthreads();
    for (int job = nb - 1 - bid; job < CVT_TOTAL; job += nb) cvt_job(p, job, (float*)smem);
    xcd_barrier(xb);
  }
  for (int rep = 0; rep <= XREP_P1; ++rep) {
    for (int t = bid; t < NTOK; t += nb) norm1_row(p, t, red);
    xcd_barrier(xb);
  }
  for (int rep = 0; rep <= XREP_P2; ++rep) {
    for (int t = bid; t < (NTOK / 128) * 26; t += nb) proj_tile(p, t, smem);
    xcd_barrier(xb);
  }
  for (int rep = 0; rep <= XREP_P3; ++rep) {
    for (int t = bid; t < (NTOK / 128) * 16; t += nb) mla_up_tile(p, t, smem);
    xcd_barrier(xb);
  }
  {
    int* qi = (int*)(smem + HG_SMEM);
    for (;;) {
      __syncthreads();
      if (tid == 0) *qi = atomicAdd(&p.qctr[0], 1);
      __syncthreads();
      int it = *qi;
      if (it >= N_HG_ITEMS + N_ATT_ITEMS) break;
      if (it < N_HG_ITEMS) hgrn_item(p, it, smem);
      else attn_item(p, it - N_HG_ITEMS, smem);
    }
    for (int rep = 0; rep < XREP_ATT; ++rep) {
      xcd_barrier(xb);
      for (;;) {
        __syncthreads();
        if (tid == 0) *qi = atomicAdd(&p.qctr[1], 1);
        __syncthreads();
        int it = *qi;
        if (it >= N_ATT_ITEMS) break;
        attn_item(p, it, smem);
      }
    }
    for (int rep = 0; rep < XREP_HG; ++rep) {
      xcd_barrier(xb);
      for (;;) {
        __syncthreads();
        if (tid == 0) *qi = atomicAdd(&p.qctr[2], 1);
        __syncthreads();
        int it = *qi;
        if (it >= N_HG_ITEMS) break;
        hgrn_item(p, it, smem);
      }
    }
  }
  xcd_barrier(xb);
  for (int rep = 0; rep <= XREP_P5; ++rep) {
    for (int t = bid; t < (NTOK / 128) * 8; t += nb) outproj_tile(p, t, smem);
    xcd_barrier(xb);
  }
  for (int g = bid; g < NTOK / 8; g += nb) route_group(p, g, smem);
  xcd_barrier(xb);
  for (int rep = 0; rep <= XREP_MOE; ++rep) {
  for (int w = bid;; w += nb) {
    int tile = w >> 3, nbk = w & 7, e, r0, nrows;
    if (!moe_tile(p.cnt, tile, 128, e, r0, nrows)) break;
    moe_up_tile(p, e, r0, nrows, nbk, smem);
  }
  xcd_barrier(xb);
  for (int w = bid;; w += nb) {
    int tile = w >> 3, nbk = w & 7, e, r0, nrows;
    if (!moe_tile(p.cnt, tile, 128, e, r0, nrows)) break;
    moe_down_tile(p, e, r0, nrows, nbk, smem);
  }
  xcd_barrier(xb);
  }
  for (int t = bid; t < NTOK; t += nb) final_row(p, t);
}

static inline size_t align_up(size_t v, size_t a) { return (v + a - 1) / a * a; }

extern "C" void kernel_launch(void* const* d_in, const int* in_sizes, int n_in, void* d_out, int out_size, void* d_ws,
                              size_t ws_size, hipStream_t stream) {
  Params p{};
  p.x = (const float*)d_in[0]; p.c = (const float*)d_in[1]; p.pos = (const int*)d_in[2];
  p.ada_w = (const float*)d_in[3]; p.ada_b = (const float*)d_in[4]; p.norm1_g = (const float*)d_in[5];
  p.w_in = (const float*)d_in[6]; p.qa_g = (const float*)d_in[7]; p.wq_up = (const float*)d_in[8];
  p.kva_g = (const float*)d_in[9]; p.wkv_up = (const float*)d_in[10]; p.qn_g = (const float*)d_in[11];
  p.kn_g = (const float*)d_in[12]; p.lb_logits = (const float*)d_in[13]; p.hg_norm_g = (const float*)d_in[14];
  p.w_out = (const float*)d_in[15]; p.norm2_g = (const float*)d_in[16]; p.rg_w = (const float*)d_in[17];
  p.rg_b = (const float*)d_in[18]; p.re_w = (const float*)d_in[19]; p.re_b = (const float*)d_in[20];
  p.w_gate = (const float*)d_in[21]; p.w_up = (const float*)d_in[22]; p.w_down = (const float*)d_in[23];
  p.out = (float*)d_out;
  char* ws = (char*)d_ws;
  size_t off = 0;
  auto take = [&](size_t bytes) { size_t o = off; off = align_up(off + bytes, 256); return ws + o; };
  p.mod = (float*)take(16 * 6144 * 4);
  p.lb = (float*)take(2 * HG_W * 4);
  p.cs = (float*)take((size_t)NTOK * 32 * 4);
  p.ewt = (float*)take((size_t)NTOK * 2 * 4);
  p.cnt = (int*)take(N_EXP * CNT_STRIDE * 4);
  p.qctr = (int*)take(16);
  p.hcnt = (int*)take(64 * 4);
  p.bar = (unsigned*)take(XCD_BAR_WORDS * 4);
  p.rwt = (float*)take(48 * 1024 * 4);
  p.list = (int*)take((size_t)N_EXP * 65536 * 4);
  p.h = (bf16_t*)take((size_t)NTOK * D_MODEL * 2);
  p.proj = (bf16_t*)take((size_t)NTOK * IN_COLS * 2);
  p.mix = (bf16_t*)take((size_t)NTOK * D_MODEL * 2);
  p.wgu_t = (bf16_t*)take((size_t)N_EXP * 1024 * 1024 * 2);
  p.wd_t = (bf16_t*)take((size_t)N_EXP * 1024 * 512 * 2);
  p.w_in_t = (bf16_t*)take((size_t)3328 * 1024 * 2);
  p.wq_t = (bf16_t*)take((size_t)800 * 384 * 2);
  p.wkv_t = (bf16_t*)take((size_t)1024 * 256 * 2);
  p.w_out_t = (bf16_t*)take((size_t)1024 * 1024 * 2);
  p.hiT = (bf16_t*)take((size_t)NTOK * HG_W * 2);
  p.of16 = p.h;
  p.hid = p.proj;
  p.y = p.proj + (size_t)NASSIGN * D_EXP;
  p.Q = (bf16_t*)d_out;
  p.Kk = p.Q + (size_t)NTOK * MLA_HEADS * QK_DIM;
  p.V = p.Kk + (size_t)NTOK * MLA_HEADS * QK_DIM;
  (void)ws_size; (void)in_sizes; (void)n_in; (void)out_size;

  static int grid_blocks = 0;
  if (!grid_blocks) {
    int dev = 0, cus = 0, per_cu = 0;
    (void)hipGetDevice(&dev);
    (void)hipDeviceGetAttribute(&cus, hipDeviceAttributeMultiprocessorCount, dev);
    (void)hipOccupancyMaxActiveBlocksPerMultiprocessor(&per_cu, k_mega, 256, 0);
    if (per_cu > 2) per_cu = 2;
    grid_blocks = cus * per_cu;
  }
  (void)hipMemsetAsync(p.bar, 0, XCD_BAR_WORDS * 4, stream);
  void* args[] = {&p};
  hipError_t e = hipLaunchCooperativeKernel((void*)k_mega, dim3(grid_blocks), dim3(256), args, 0, stream);
  if (e != hipSuccess) fprintf(stderr, "cooperative launch failed: %s (grid %d)\n", hipGetErrorString(e), grid_blocks);
}
```
